# Optimizing an MI355X kernel written in HIP

```python
import math
import jax, jax.numpy as jnp
from jax import lax
import numpy as np

D_MODEL = 1024
BATCH = 8
SEQ = 8192
DEPTH = 2

CHUNK = 64
LEFT_CHUNKS = 8
BAND = (LEFT_CHUNKS + 1) * CHUNK
HEAD_DIM = 64
A_HEADS = 8
B_HEADS = 4
C_HEADS = 8
A_WIDTH = A_HEADS * HEAD_DIM
B_WIDTH = B_HEADS * 2 * HEAD_DIM
C_WIDTH = C_HEADS * HEAD_DIM
IN_WIDTH = 3 * A_WIDTH + 3 * B_WIDTH + 3 * C_WIDTH + C_HEADS
N_BRANCH = 3
D_FF = 4 * D_MODEL
REL_CLIP = 128
ROPE_THETA = 500000.0
ROPE_DIM = HEAD_DIM // 4
Q_BLOCK = 128
EPS = 1e-6

kernel_name = "streaming_hybrid_gated_attention_trunk"


def rmsnorm(x, g):
    xf = x.astype(jnp.float32)
    y = xf * lax.rsqrt(jnp.mean(xf * xf, axis=-1, keepdims=True) + EPS)
    return (y * g.astype(jnp.float32)).astype(x.dtype)


def partial_rope(x, positions):
    half = ROPE_DIM // 2
    inv_freq = jnp.power(ROPE_THETA, -jnp.arange(0, ROPE_DIM, 2, dtype=jnp.float32) / ROPE_DIM)
    ang = positions.astype(jnp.float32)[..., None] * inv_freq
    ang = ang.reshape(ang.shape[:2] + (1,) * (x.ndim - 3) + (half,))
    cos, sin = jnp.cos(ang), jnp.sin(ang)
    xf = x.astype(jnp.float32)
    x1, x2, rest = xf[..., :half], xf[..., half:ROPE_DIM], xf[..., ROPE_DIM:]
    out = jnp.concatenate([x1 * cos - x2 * sin, x2 * cos + x1 * sin, rest], axis=-1)
    return out.astype(x.dtype)


def chunked_relbias_attention(q, k, v, rel_bias):
    B, S, H, dh = q.shape
    nc = S // CHUNK
    pad = LEFT_CHUNKS * CHUNK
    k_pad = jnp.pad(k, ((0, 0), (pad, 0), (0, 0), (0, 0)))
    v_pad = jnp.pad(v, ((0, 0), (pad, 0), (0, 0), (0, 0)))
    qc = q.reshape(B, nc, CHUNK, H, dh).transpose(1, 0, 2, 3, 4)
    q_off = jnp.arange(CHUNK)
    k_off = jnp.arange(BAND) - pad
    rel = jnp.clip(k_off[None, :] - q_off[:, None], -REL_CLIP, REL_CLIP) + REL_CLIP
    bias = rel_bias[:, rel].astype(jnp.float32)
    scale = dh ** -0.5

    def one_chunk(args):
        c, qb = args
        kb = lax.dynamic_slice_in_dim(k_pad, c * CHUNK, BAND, axis=1)
        vb = lax.dynamic_slice_in_dim(v_pad, c * CHUNK, BAND, axis=1)
        s = jnp.einsum('bqhd,bkhd->bhqk', qb, kb, preferred_element_type=jnp.float32) * scale + bias
        valid = (c * CHUNK + k_off) >= 0
        s = jnp.where(valid[None, None, None, :], s, -jnp.inf)
        p = jax.nn.softmax(s, axis=-1)
        return jnp.einsum('bhqk,bkhd->bqhd', p.astype(vb.dtype), vb)

    out = lax.map(one_chunk, (jnp.arange(nc), qc))
    return out.transpose(1, 0, 2, 3, 4).reshape(B, S, H * dh)


def differential_attention(q, k, v, lambdas, sub_gain, lam_init):
    B, S, H, _, dh = q.shape
    nb = S // Q_BLOCK
    scale = dh ** -0.5
    lf = lambdas.astype(jnp.float32)
    lam = jnp.exp(jnp.sum(lf[0] * lf[1])) - jnp.exp(jnp.sum(lf[2] * lf[3])) + lam_init
    qb = q.reshape(B, nb, Q_BLOCK, H, 2, dh).transpose(1, 0, 2, 3, 4, 5)
    key_chunk = jnp.arange(S) // CHUNK

    def one_block(args):
        i, qi = args
        q_chunk = (i * Q_BLOCK + jnp.arange(Q_BLOCK)) // CHUNK
        mask = key_chunk[None, :] <= q_chunk[:, None]
        s = jnp.einsum('bqhcd,bkhcd->bhcqk', qi, k, preferred_element_type=jnp.float32) * scale
        s = jnp.where(mask, s, -jnp.inf)
        p = jax.nn.softmax(s, axis=-1)
        pd = p[:, :, 0] - lam * p[:, :, 1]
        return jnp.einsum('bhqk,bkhe->bqhe', pd.astype(v.dtype), v)

    o = lax.map(one_block, (jnp.arange(nb), qb))
    o = o.transpose(1, 0, 2, 3, 4).reshape(B, S, H, 2 * dh)
    o = rmsnorm(o, sub_gain) * (1.0 - lam_init)
    return o.reshape(B, S, H * 2 * dh)


def forgetting_attention(q, k, v, f_logit):
    B, S, H, dh = q.shape
    nb = S // Q_BLOCK
    scale = dh ** -0.5
    F = jnp.cumsum(jax.nn.log_sigmoid(f_logit.astype(jnp.float32)), axis=1)
    F_k = F.transpose(0, 2, 1)
    qb = q.reshape(B, nb, Q_BLOCK, H, dh).transpose(1, 0, 2, 3, 4)
    Fq = F.reshape(B, nb, Q_BLOCK, H).transpose(1, 0, 3, 2)
    k_pos = jnp.arange(S)

    def one_block(args):
        i, qi, fq = args
        q_pos = i * Q_BLOCK + jnp.arange(Q_BLOCK)
        mask = k_pos[None, :] <= q_pos[:, None]
        s = jnp.einsum('bqhd,bkhd->bhqk', qi, k, preferred_element_type=jnp.float32) * scale
        s = s + (fq[..., None] - F_k[:, :, None, :])
        s = jnp.where(mask, s, -jnp.inf)
        p = jax.nn.softmax(s, axis=-1)
        return jnp.einsum('bhqk,bkhd->bqhd', p.astype(v.dtype), v)

    o = lax.map(one_block, (jnp.arange(nb), qb, Fq))
    return o.transpose(1, 0, 2, 3, 4).reshape(B, S, H * dh)


def split_columns(proj):
    sizes = (A_WIDTH,) * 3 + (B_WIDTH,) * 3 + (C_WIDTH,) * 3 + (C_HEADS,)
    outs = []
    start = 0
    for n in sizes:
        outs.append(proj[..., start:start + n])
        start += n
    return outs


def hybrid_layer(x, positions, norm_mix, w_in, rel_bias, lambdas, sub_gain, b_forget,
                 w_br_a, w_br_b, w_br_c, w_gate, b_gate, w_out, norm_mlp, w_ff1, w_ff2, layer_idx):
    B, S, D = x.shape
    h = rmsnorm(x, norm_mix)
    proj = h @ w_in
    qa, ka, va, qb, kb, vb, qc, kc, vc, fl = split_columns(proj)
    ya = chunked_relbias_attention(qa.reshape(B, S, A_HEADS, HEAD_DIM), ka.reshape(B, S, A_HEADS, HEAD_DIM),
                                   va.reshape(B, S, A_HEADS, HEAD_DIM), rel_bias)
    lam_init = 0.8 - 0.6 * math.exp(-0.3 * layer_idx)
    qb = partial_rope(qb.reshape(B, S, B_HEADS, 2, HEAD_DIM), positions)
    kb = partial_rope(kb.reshape(B, S, B_HEADS, 2, HEAD_DIM), positions)
    yb = differential_attention(qb, kb, vb.reshape(B, S, B_HEADS, 2 * HEAD_DIM), lambdas, sub_gain, lam_init)
    yc = forgetting_attention(qc.reshape(B, S, C_HEADS, HEAD_DIM), kc.reshape(B, S, C_HEADS, HEAD_DIM),
                              vc.reshape(B, S, C_HEADS, HEAD_DIM), fl + b_forget)
    g = jax.nn.sigmoid((h @ w_gate + b_gate).astype(jnp.float32)).astype(x.dtype).reshape(B, S, N_BRANCH, D)
    merged = g[:, :, 0] * (ya @ w_br_a) + g[:, :, 1] * (yb @ w_br_b) + g[:, :, 2] * (yc @ w_br_c)
    x = x + merged @ w_out
    h2 = rmsnorm(x, norm_mlp)
    x = x + jnp.square(jax.nn.relu(h2 @ w_ff1)) @ w_ff2
    return x


def setup_inputs(seed: int = 0) -> dict:
    key = jax.random.key(seed)
    ks = jax.random.split(key, 20)
    f32 = jnp.float32
    nrm = lambda k, shape, s: jax.random.normal(k, shape, f32) * s
    x = nrm(ks[0], (BATCH, SEQ, D_MODEL), 1.0)
    offset = jax.random.randint(ks[1], (BATCH, 1), 0, 64, dtype=jnp.int32) * CHUNK
    positions = (offset + jnp.arange(SEQ, dtype=jnp.int32)[None, :]).astype(jnp.int32)
    return {
        "x": x,
        "positions": positions,
        "norm_mix": 1.0 + nrm(ks[2], (DEPTH, D_MODEL), 0.02),
        "w_in": nrm(ks[3], (DEPTH, D_MODEL, IN_WIDTH), D_MODEL ** -0.5),
        "rel_bias": nrm(ks[4], (DEPTH, A_HEADS, 2 * REL_CLIP + 1), 0.5),
        "lambdas": nrm(ks[5], (DEPTH, 4, HEAD_DIM), 0.1),
        "sub_gain": 1.0 + nrm(ks[6], (DEPTH, 2 * HEAD_DIM), 0.02),
        "b_forget": 2.0 + nrm(ks[7], (DEPTH, C_HEADS), 0.5),
        "w_br_a": nrm(ks[8], (DEPTH, A_WIDTH, D_MODEL), A_WIDTH ** -0.5),
        "w_br_b": nrm(ks[9], (DEPTH, B_WIDTH, D_MODEL), B_WIDTH ** -0.5),
        "w_br_c": nrm(ks[10], (DEPTH, C_WIDTH, D_MODEL), C_WIDTH ** -0.5),
        "w_gate": nrm(ks[11], (DEPTH, D_MODEL, N_BRANCH * D_MODEL), D_MODEL ** -0.5),
        "b_gate": nrm(ks[12], (DEPTH, N_BRANCH * D_MODEL), 0.02),
        "w_out": nrm(ks[13], (DEPTH, D_MODEL, D_MODEL), D_MODEL ** -0.5),
        "norm_mlp": 1.0 + nrm(ks[14], (DEPTH, D_MODEL), 0.02),
        "w_ff1": nrm(ks[15], (DEPTH, D_MODEL, D_FF), D_MODEL ** -0.5),
        "w_ff2": nrm(ks[16], (DEPTH, D_FF, D_MODEL), D_FF ** -0.5),
        "final_norm": 1.0 + nrm(ks[17], (D_MODEL,), 0.02),
    }


def reference(x, positions, norm_mix, w_in, rel_bias, lambdas, sub_gain, b_forget,
              w_br_a, w_br_b, w_br_c, w_gate, b_gate, w_out, norm_mlp, w_ff1, w_ff2, final_norm):
    for l in range(DEPTH):
        x = hybrid_layer(x, positions, norm_mix[l], w_in[l], rel_bias[l], lambdas[l], sub_gain[l], b_forget[l],
                         w_br_a[l], w_br_b[l], w_br_c[l], w_gate[l], b_gate[l], w_out[l],
                         norm_mlp[l], w_ff1[l], w_ff2[l], l)
    return rmsnorm(x, final_norm)
```

```cpp
#include <hip/hip_runtime.h>
#include <hip/hip_cooperative_groups.h>
#include <cstdio>
#include <cstdint>
#include <cmath>
namespace cg = cooperative_groups;
namespace pg8 {
#define PG8_LAS __attribute__((address_space(3)))
typedef unsigned short bf16_t;
typedef short bf16x8 __attribute__((ext_vector_type(8)));
typedef float f32x4 __attribute__((ext_vector_type(4)));
typedef unsigned u32x4 __attribute__((ext_vector_type(4)));
typedef unsigned u32x2v __attribute__((ext_vector_type(2)));
constexpr int BM = 256, BK = 64, HALF = 128, HTB = HALF * BK * 2  , STAGE_BYTES = 8 * HTB, NXCD = 8, WGM = 8;

__host__ __device__ __forceinline__ int lds_byte(int r, int c) { const int st = (r >> 4) * 2 + (c >> 5), rr = r & 15, cc = c & 31, ob = rr * 64 + cc * 2; return st * 1024 + (ob ^ (((ob >> 9) & 1) << 5)); }
__host__ __device__ __forceinline__ void stage_rc(int b, int& R, int& C) { const int st = b / 1024, sb = b % 1024, swz = sb ^ (((sb >> 9) & 1) << 5); R = (st >> 1) * 16 + swz / 64; C = (st & 1) * 32 + (swz % 64) / 2; }
__host__ __device__ __forceinline__ int perm32(int rho) { const int n = rho >> 4, i = rho & 15; return 8 * (i >> 2) + 4 * n + (i & 3); }

struct Unit { int pm, pn; };
struct Gemm { const bf16_t* A; const bf16_t* Bt; int M, N, K; };

struct StaticOrder {
    int nM, nN, nwg, G, c;
    __host__ __device__ void init(int M, int N, int G_, int c_) { nM = M / BM; nN = N / BM; nwg = nM * nN; G = G_; c = c_; }
    __host__ __device__ bool next(int i, Unit& u) const {
        const long L = (long)i * G + c; if (L >= nwg) return false;
        int wgid = (int)L; { const int q = nwg / NXCD, r = nwg % NXCD, xcd = wgid % NXCD, off = wgid / NXCD; wgid = (xcd < r ? xcd * (q + 1) : r * (q + 1) + (xcd - r) * q) + off; }
        const int nig = WGM * nN, gid = wgid / nig, fm = gid * WGM, gsz = (nM - fm) < WGM ? (nM - fm) : WGM;
        u.pm = fm + ((wgid % nig) % gsz); u.pn = (wgid % nig) / gsz; return true;
    }
    __device__ __forceinline__ void a_ready(const Unit&) const {}
    __device__ __forceinline__ void done(const Unit&) const {}
};

__device__ __forceinline__ unsigned cvt_pk_bf16(float lo, float hi) { unsigned r; asm volatile("v_cvt_pk_bf16_f32 %0, %1, %2" : "=v"(r) : "v"(lo), "v"(hi)); return r; }
template <class Epi, class Sched, bool ALIGN_EPI = false, bool SP2 = false>
__device__ __forceinline__ void gemm_phase(PG8_LAS unsigned char* lds, const Gemm g, const Sched& S, const Epi& E) {
    int tid_ = threadIdx.x; asm volatile("" : "+v"(tid_));
    const int tid = tid_, wid = __builtin_amdgcn_readfirstlane(tid >> 6), lane = tid & 63, wr = wid >> 2, wc = wid & 3, fr = lane & 15, fq = lane >> 4;
    const int K = g.K, nt = K / BK;
    unsigned voffA[2], voffB[2];
#pragma unroll
    for (int i = 0; i < 2; ++i) { int R, C; stage_rc(tid * 16 + i * 8192, R, C); const int Rb = Epi::PERM ? ((R & ~31) + perm32(R & 31)) : R;
        voffA[i] = (unsigned)(R * K + C) * 2u; voffB[i] = (unsigned)(Rb * K + C) * 2u; }
    const size_t kstep = (size_t)(BK * 2);
    const size_t hstep = (size_t)HALF * K * 2;
    const size_t tstep = 2 * hstep;
    const unsigned ldsw = (unsigned)wid * 1024u;
    const int aoff = lds_byte(wr * 64 + fr, fq * 8), boff = lds_byte(wc * 32 + fr, fq * 8);
#define PG8_SA(b, h) (((b) * 2 + (h)) * HTB)
#define PG8_SB(b, h) ((4 + (b) * 2 + (h)) * HTB)
#define PG8_STAGE(bufoff, gbase, voff) do { _Pragma("unroll") for (int _i = 0; _i < 2; ++_i) \
        __builtin_amdgcn_global_load_lds((const unsigned*)((const char*)(gbase) + (voff)[_i]), (PG8_LAS unsigned*)(lds + (bufoff) + ldsw + _i * 8192), 16, 0, 0); } while (0)
#define PG8_LDA(dst, b, h) do { _Pragma("unroll") for (int m = 0; m < 4; ++m) _Pragma("unroll") for (int k = 0; k < 2; ++k) dst[m][k] = *(const PG8_LAS bf16x8*)(lds + PG8_SA(b, h) + aoff + m * 2048 + k * 1024); } while (0)
#define PG8_LDB(dst, b, h) do { _Pragma("unroll") for (int n = 0; n < 2; ++n) _Pragma("unroll") for (int k = 0; k < 2; ++k) dst[n][k] = *(const PG8_LAS bf16x8*)(lds + PG8_SB(b, h) + boff + n * 2048 + k * 1024); } while (0)
#define PG8_MMA(ai, bj, At, Bt) do { __builtin_amdgcn_s_setprio(1); _Pragma("unroll") for (int m = 0; m < 4; ++m) _Pragma("unroll") for (int n = 0; n < 2; ++n) _Pragma("unroll") for (int k = 0; k < 2; ++k) \
        acc[ai][bj][m][n] = __builtin_amdgcn_mfma_f32_16x16x32_bf16(Bt[n][k], At[m][k], acc[ai][bj][m][n], 0, 0, 0); __builtin_amdgcn_s_setprio(0); } while (0)
#define PG8_WAIT_V(n) asm volatile("s_waitcnt vmcnt(" #n ")" ::: "memory")
#define PG8_WAIT_L(n) asm volatile("s_waitcnt lgkmcnt(" #n ")" ::: "memory")
#define PG8_BAR __builtin_amdgcn_s_barrier()
#define PG8_SCHED __builtin_amdgcn_sched_barrier(0)
    Unit cur, nxt; int ui = 0;
    if (!S.next(0, cur)) return;
    f32x4 acc[2][2][4][2];
#pragma unroll
    for (int a = 0; a < 2; ++a)
#pragma unroll
        for (int b = 0; b < 2; ++b)
#pragma unroll
            for (int m = 0; m < 4; ++m)
#pragma unroll
                for (int n = 0; n < 2; ++n) acc[a][b][m][n] = (f32x4){0.f, 0.f, 0.f, 0.f};
    bf16x8 At[4][2], B0[2][2], B1[2][2];
    const char* cA = (const char*)g.A + (size_t)cur.pm * tstep; const char* cB = (const char*)g.Bt + (size_t)cur.pn * tstep;
    S.a_ready(cur);
    if constexpr (SP2) {
        PG8_STAGE(PG8_SB(0, 0), cB, voffB); PG8_STAGE(PG8_SB(0, 1), cB + hstep, voffB); PG8_STAGE(PG8_SA(0, 0), cA, voffA); PG8_STAGE(PG8_SA(0, 1), cA + hstep, voffA);
        if (wr == 1) PG8_BAR;
        PG8_WAIT_V(2); PG8_BAR;
        PG8_STAGE(PG8_SB(1, 0), cB + kstep, voffB); PG8_STAGE(PG8_SA(1, 0), cA + kstep, voffA); PG8_STAGE(PG8_SB(1, 1), cB + hstep + kstep, voffB);
        PG8_WAIT_V(6); PG8_BAR;
    } else {
        PG8_STAGE(PG8_SB(0, 0), cB, voffB); PG8_STAGE(PG8_SA(0, 0), cA, voffA); PG8_STAGE(PG8_SB(0, 1), cB + hstep, voffB); PG8_STAGE(PG8_SA(0, 1), cA + hstep, voffA);
        if (wr == 1) PG8_BAR;
        PG8_WAIT_V(4); PG8_BAR;
        PG8_STAGE(PG8_SB(1, 0), cB + kstep, voffB); PG8_STAGE(PG8_SA(1, 0), cA + kstep, voffA); PG8_STAGE(PG8_SB(1, 1), cB + hstep + kstep, voffB);
        PG8_WAIT_V(6); PG8_BAR;
    }
    for (;;) {
        const bool has_next = S.next(ui + 1, nxt);
        const char* nA = has_next ? (const char*)g.A + (size_t)nxt.pm * tstep : cA; const char* nB = has_next ? (const char*)g.Bt + (size_t)nxt.pn * tstep : cB;
        for (int t = 0; t < nt; t += 2) {
            const bool last = (t == nt - 2);
            const char* a1 = cA + (size_t)(t + 1) * kstep;
            const char* a2 = last ? nA : cA + (size_t)(t + 2) * kstep; const char* b2 = last ? nB : cB + (size_t)(t + 2) * kstep;
            const char* a3 = a2 + kstep; const char* b3 = b2 + kstep;
            if (last && has_next) S.a_ready(nxt);
            if constexpr (SP2) {
            PG8_LDB(B0, 0, 0); PG8_LDB(B1, 0, 1); PG8_SCHED; PG8_LDA(At, 0, 0); PG8_STAGE(PG8_SA(1, 1), a1 + hstep, voffA);
            PG8_WAIT_V(8); PG8_WAIT_L(0); PG8_BAR; PG8_MMA(0, 0, At, B0); PG8_MMA(0, 1, At, B1); PG8_BAR; PG8_SCHED;
            PG8_LDA(At, 0, 1); PG8_STAGE(PG8_SB(0, 0), b2, voffB); PG8_STAGE(PG8_SB(0, 1), b2 + hstep, voffB); PG8_STAGE(PG8_SA(0, 0), a2, voffA);
            PG8_WAIT_V(8); PG8_WAIT_L(0); PG8_BAR; PG8_MMA(1, 0, At, B0); PG8_MMA(1, 1, At, B1); PG8_BAR; PG8_SCHED;
            PG8_LDB(B0, 1, 0); PG8_LDB(B1, 1, 1); PG8_SCHED; PG8_LDA(At, 1, 0); PG8_STAGE(PG8_SA(0, 1), a2 + hstep, voffA);
            PG8_WAIT_V(8); PG8_WAIT_L(0); PG8_BAR; PG8_MMA(0, 0, At, B0); PG8_MMA(0, 1, At, B1); PG8_BAR; PG8_SCHED;
            PG8_LDA(At, 1, 1); PG8_STAGE(PG8_SB(1, 0), b3, voffB); PG8_STAGE(PG8_SB(1, 1), b3 + hstep, voffB); PG8_STAGE(PG8_SA(1, 0), a3, voffA);
            PG8_WAIT_V(8); PG8_WAIT_L(0); PG8_BAR; PG8_MMA(1, 0, At, B0); PG8_MMA(1, 1, At, B1); PG8_BAR; PG8_SCHED;
            } else {
            PG8_LDB(B0, 0, 0); PG8_SCHED; PG8_LDA(At, 0, 0); PG8_STAGE(PG8_SA(1, 1), a1 + hstep, voffA);
            PG8_WAIT_L(8); PG8_BAR; PG8_WAIT_L(0); PG8_MMA(0, 0, At, B0); PG8_BAR; PG8_SCHED;
            PG8_LDB(B1, 0, 1); PG8_STAGE(PG8_SB(0, 0), b2, voffB);
            PG8_BAR; PG8_WAIT_L(0); PG8_MMA(0, 1, At, B1); PG8_BAR;
            PG8_LDA(At, 0, 1); PG8_STAGE(PG8_SA(0, 0), a2, voffA);
            PG8_BAR; PG8_WAIT_L(0); PG8_MMA(1, 0, At, B0); PG8_BAR; PG8_SCHED;
            PG8_STAGE(PG8_SB(0, 1), b2 + hstep, voffB);
            PG8_WAIT_V(6); PG8_BAR; PG8_MMA(1, 1, At, B1); PG8_BAR;
            PG8_LDB(B0, 1, 0); PG8_SCHED; PG8_LDA(At, 1, 0); PG8_STAGE(PG8_SA(0, 1), a2 + hstep, voffA);
            PG8_WAIT_L(8); PG8_BAR; PG8_WAIT_L(0); PG8_MMA(0, 0, At, B0); PG8_BAR; PG8_SCHED;
            PG8_LDB(B1, 1, 1); PG8_STAGE(PG8_SB(1, 0), b3, voffB);
            PG8_BAR; PG8_WAIT_L(0); PG8_MMA(0, 1, At, B1); PG8_BAR;
            PG8_LDA(At, 1, 1); PG8_STAGE(PG8_SA(1, 0), a3, voffA);
            PG8_BAR; PG8_WAIT_L(0); PG8_MMA(1, 0, At, B0); PG8_BAR; PG8_SCHED;
            PG8_STAGE(PG8_SB(1, 1), b3 + hstep, voffB);
            PG8_WAIT_V(6); PG8_BAR; PG8_MMA(1, 1, At, B1); PG8_BAR;
            }
        }
        if constexpr (ALIGN_EPI) { if (wr == 0) PG8_BAR; }
        if constexpr (!Epi::AFTER_DRAIN) { E(acc, cur, wr, wc, fr, fq); S.done(cur); }
        if (!has_next) break;
#pragma unroll
        for (int a = 0; a < 2; ++a)
#pragma unroll
            for (int b = 0; b < 2; ++b)
#pragma unroll
                for (int m = 0; m < 4; ++m)
#pragma unroll
                    for (int n = 0; n < 2; ++n) acc[a][b][m][n] = (f32x4){0.f, 0.f, 0.f, 0.f};
        cur = nxt; cA = nA; cB = nB; ++ui;
        if constexpr (ALIGN_EPI) { if (wr == 1) PG8_BAR; }
    }
    PG8_WAIT_V(0);
    if constexpr (!ALIGN_EPI) { if (wr == 0) PG8_BAR; }
    PG8_BAR;
    if constexpr (Epi::AFTER_DRAIN) { E.fused(acc, cur, wr, wc, fr, fq, lds, wid, lane); S.done(cur); }
#undef PG8_SA
#undef PG8_SB
#undef PG8_STAGE
#undef PG8_LDA
#undef PG8_LDB
#undef PG8_MMA
#undef PG8_WAIT_V
#undef PG8_WAIT_L
#undef PG8_BAR
#undef PG8_SCHED
}
}
namespace pg8 {
__device__ __forceinline__ float bf_lo(unsigned w) { return __uint_as_float(w << 16); }
__device__ __forceinline__ float bf_hi(unsigned w) { return __uint_as_float(w & 0xffff0000u); }
__device__ __forceinline__ u32x4 pack8(f32x4 v0, f32x4 v1) { u32x4 w; w.x = cvt_pk_bf16(v0[0], v0[1]); w.y = cvt_pk_bf16(v0[2], v0[3]); w.z = cvt_pk_bf16(v1[0], v1[1]); w.w = cvt_pk_bf16(v1[2], v1[3]); return w; }
template <int MODE> struct EpiBf {
    static constexpr bool PERM = true, AFTER_DRAIN = false;
    bf16_t* O; size_t ldc; const float* bias; float qscale;
    __device__ __forceinline__ void operator()(const f32x4 (&acc)[2][2][4][2], const Unit& u, int wr, int wc, int fr, int fq) const {
        const int row0 = u.pm * BM + wr * 64 + fr; const int col0 = u.pn * BM + wc * 32 + 8 * fq;
        float sc = 1.f; if (MODE == 1) { if (((u.pn >> 1) & 1) == 0) sc = qscale; }
        float rs[2][4];
#pragma unroll
        for (int ai = 0; ai < 2; ++ai)
#pragma unroll
            for (int m = 0; m < 4; ++m) rs[ai][m] = (MODE == 4) ? bias[row0 + ai * HALF + m * 16] : 1.f;
        f32x4 bv[2][2];
#pragma unroll
        for (int bj = 0; bj < 2; ++bj)
#pragma unroll
            for (int n = 0; n < 2; ++n) bv[bj][n] = (MODE == 2) ? *(const f32x4*)(bias + col0 + bj * HALF + 4 * n) : (f32x4){0.f, 0.f, 0.f, 0.f};
#pragma unroll
        for (int ai = 0; ai < 2; ++ai)
#pragma unroll
            for (int m = 0; m < 4; ++m) { bf16_t* rowp = O + (size_t)(row0 + ai * HALF + m * 16) * ldc + col0;
#pragma unroll
                for (int bj = 0; bj < 2; ++bj) { f32x4 v0 = acc[ai][bj][m][0], v1 = acc[ai][bj][m][1];
                    if (MODE == 1) { v0 = v0 * sc; v1 = v1 * sc; }
                    if (MODE == 2) { v0 = v0 + bv[bj][0]; v1 = v1 + bv[bj][1];
#pragma unroll
                        for (int e = 0; e < 4; ++e) { v0[e] = __builtin_amdgcn_rcpf(1.0f + __builtin_amdgcn_exp2f(-1.4426950408889634f * v0[e])); v1[e] = __builtin_amdgcn_rcpf(1.0f + __builtin_amdgcn_exp2f(-1.4426950408889634f * v1[e])); } }
                    if (MODE == 3) {
#pragma unroll
                        for (int e = 0; e < 4; ++e) { const float a0 = fmaxf(v0[e], 0.f), a1 = fmaxf(v1[e], 0.f); v0[e] = a0 * a0; v1[e] = a1 * a1; } }
                    if (MODE == 4) { const float r_ = rs[ai][m];
#pragma unroll
                        for (int e = 0; e < 4; ++e) { const float a0 = fmaxf(v0[e], 0.f), a1 = fmaxf(v1[e], 0.f); v0[e] = a0 * a0 * r_; v1[e] = a1 * a1 * r_; } }
                    *(u32x4*)(rowp + bj * HALF) = pack8(v0, v1); } }
    }
};
template <bool FIRST> struct EpiBranch {
    static constexpr bool PERM = true, AFTER_DRAIN = false;
    bf16_t* Mg; const bf16_t* G; int gcol0; const float* gbias;
    __device__ __forceinline__ void operator()(const f32x4 (&acc)[2][2][4][2], const Unit& u, int wr, int wc, int fr, int fq) const {
        const int row0 = u.pm * BM + wr * 64 + fr; const int col0 = u.pn * BM + wc * 32 + 8 * fq;
        f32x4 bb[2][2];
#pragma unroll
        for (int bj = 0; bj < 2; ++bj)
#pragma unroll
            for (int n = 0; n < 2; ++n) bb[bj][n] = *(const f32x4*)(gbias + gcol0 + col0 + bj * HALF + 4 * n);
#pragma unroll
        for (int ai = 0; ai < 2; ++ai) {
#pragma unroll
          for (int mp = 0; mp < 2; ++mp) {
            u32x4 gq[2][2], mo[2][2];
#pragma unroll
            for (int mi = 0; mi < 2; ++mi)
#pragma unroll
                for (int bj = 0; bj < 2; ++bj) { const size_t row = (size_t)(row0 + ai * HALF + (2 * mp + mi) * 16); const int col = col0 + bj * HALF;
                    gq[mi][bj] = *(const u32x4*)(G + row * 3072 + gcol0 + col);
                    if (!FIRST) mo[mi][bj] = *(const u32x4*)(Mg + row * 1024 + col); }
#pragma unroll
            for (int mi = 0; mi < 2; ++mi)
#pragma unroll
                for (int bj = 0; bj < 2; ++bj) { const int m = 2 * mp + mi; const size_t row = (size_t)(row0 + ai * HALF + m * 16); const int col = col0 + bj * HALF;
                    const u32x4 g = gq[mi][bj];
                    f32x4 g0 = (f32x4){bf_lo(g.x), bf_hi(g.x), bf_lo(g.y), bf_hi(g.y)} + bb[bj][0], g1 = (f32x4){bf_lo(g.z), bf_hi(g.z), bf_lo(g.w), bf_hi(g.w)} + bb[bj][1];
                    f32x4 v0 = acc[ai][bj][m][0], v1 = acc[ai][bj][m][1];
#pragma unroll
                    for (int e = 0; e < 4; ++e) { v0[e] *= __builtin_amdgcn_rcpf(1.0f + __builtin_amdgcn_exp2f(-1.4426950408889634f * g0[e])); v1[e] *= __builtin_amdgcn_rcpf(1.0f + __builtin_amdgcn_exp2f(-1.4426950408889634f * g1[e])); }
                    if (!FIRST) { const u32x4 o = mo[mi][bj];
                        v0[0] += bf_lo(o.x); v0[1] += bf_hi(o.x); v0[2] += bf_lo(o.y); v0[3] += bf_hi(o.y);
                        v1[0] += bf_lo(o.z); v1[1] += bf_hi(o.z); v1[2] += bf_lo(o.w); v1[3] += bf_hi(o.w); }
                    *(u32x4*)(Mg + row * 1024 + col) = pack8(v0, v1); }
          }
        }
    }
};
struct EpiResid {
    static constexpr bool PERM = false, AFTER_DRAIN = false;
    const float* base; float* out;
    __device__ __forceinline__ void operator()(const f32x4 (&acc)[2][2][4][2], const Unit& u, int wr, int wc, int fr, int fq) const {
        const int row0 = u.pm * BM + wr * 64 + fr; const int col0 = u.pn * BM + wc * 32 + 4 * fq;
#pragma unroll
        for (int ai = 0; ai < 2; ++ai) {
#pragma unroll
          for (int mp = 0; mp < 2; ++mp) {
            f32x4 bs[2][2][2];
#pragma unroll
            for (int mi = 0; mi < 2; ++mi) { const size_t off = (size_t)(row0 + ai * HALF + (2 * mp + mi) * 16) * 1024 + col0;
#pragma unroll
                for (int bj = 0; bj < 2; ++bj)
#pragma unroll
                    for (int n = 0; n < 2; ++n) bs[mi][bj][n] = *(const f32x4*)(base + off + bj * HALF + n * 16); }
#pragma unroll
            for (int mi = 0; mi < 2; ++mi) { const int m = 2 * mp + mi; const size_t off = (size_t)(row0 + ai * HALF + m * 16) * 1024 + col0;
#pragma unroll
                for (int bj = 0; bj < 2; ++bj)
#pragma unroll
                    for (int n = 0; n < 2; ++n) *(f32x4*)(out + off + bj * HALF + n * 16) = bs[mi][bj][n] + acc[ai][bj][m][n]; }
          }
        }
    }
};
struct EpiResidN {
    static constexpr bool PERM = false, AFTER_DRAIN = false;
    const float* base; float* out; bf16_t* xb; float* ssqp;
    __device__ __forceinline__ void operator()(const f32x4 (&acc)[2][2][4][2], const Unit& u, int wr, int wc, int fr, int fq) const {
        const int row0 = u.pm * BM + wr * 64 + fr; const int col0 = u.pn * BM + wc * 32 + 4 * fq;
#pragma unroll
        for (int ai = 0; ai < 2; ++ai) {
#pragma unroll
          for (int mp = 0; mp < 2; ++mp) {
            f32x4 bs[2][2][2];
#pragma unroll
            for (int mi = 0; mi < 2; ++mi) { const size_t off = (size_t)(row0 + ai * HALF + (2 * mp + mi) * 16) * 1024 + col0;
#pragma unroll
                for (int bj = 0; bj < 2; ++bj)
#pragma unroll
                    for (int n = 0; n < 2; ++n) bs[mi][bj][n] = *(const f32x4*)(base + off + bj * HALF + n * 16); }
#pragma unroll
            for (int mi = 0; mi < 2; ++mi) { const int m = 2 * mp + mi; const int row = row0 + ai * HALF + m * 16; const size_t off = (size_t)row * 1024 + col0;
                float sq = 0.f;
#pragma unroll
                for (int bj = 0; bj < 2; ++bj)
#pragma unroll
                    for (int n = 0; n < 2; ++n) { const f32x4 v = bs[mi][bj][n] + acc[ai][bj][m][n];
                        *(f32x4*)(out + off + bj * HALF + n * 16) = v;
                        u32x2v w; w.x = cvt_pk_bf16(v[0], v[1]); w.y = cvt_pk_bf16(v[2], v[3]); *(u32x2v*)(xb + off + bj * HALF + n * 16) = w;
                        sq += (v[0] * v[0] + v[1] * v[1]) + (v[2] * v[2] + v[3] * v[3]); }
                sq += __uint_as_float((unsigned)__builtin_amdgcn_ds_swizzle((int)__float_as_uint(sq), 0x401F));
                { auto rr = __builtin_amdgcn_permlane32_swap(__float_as_uint(sq), __float_as_uint(sq), false, false); sq = __uint_as_float(rr[0]) + __uint_as_float(rr[1]); }
                if (fq == 0) ssqp[(size_t)row * 16 + u.pn * 4 + wc] = sq; }
          }
        }
    }
};
}
#define LAS __attribute__((address_space(3)))
typedef unsigned short bf16_t;
typedef short bf16x8 __attribute__((ext_vector_type(8)));
typedef short s16x4 __attribute__((ext_vector_type(4)));
typedef float f32x4 __attribute__((ext_vector_type(4)));
typedef float f32x16 __attribute__((ext_vector_type(16)));
typedef unsigned u32x4 __attribute__((ext_vector_type(4)));
typedef unsigned u32x2 __attribute__((ext_vector_type(2)));
constexpr int NB = 8, S = 8192, D = 1024, T = NB * S, FF = 4096, INW = 4616, DEPTH = 2;
constexpr int QKW = 3072, VW = 1536, YW = 1536, GW = 3072;
constexpr float EPS = 1e-6f, LOG2E = 1.4426950408889634f, C2 = 0.125f * 1.4426950408889634f;
constexpr size_t MiB = 1u << 20;
constexpr size_t WS_CTL = 0, WS_W = 2 * MiB, W_LAYER = 36 * MiB;
constexpr size_t WO_QK = 0, WO_V = 6 * MiB, WO_G = 9 * MiB, WO_BR = 15 * MiB, WO_O = 18 * MiB, WO_1 = 20 * MiB, WO_2 = 28 * MiB;
constexpr size_t WS_F = 74 * MiB, WS_H = 76 * MiB, WS_QK = 204 * MiB, WS_VT = 588 * MiB, WS_Y = 780 * MiB, WS_PARK = 972 * MiB, WS_ROPE = 1004 * MiB  , WS_END = 1010 * MiB;
constexpr size_t WS_G = WS_QK, WS_MG = WS_VT, WS_FFH = WS_QK;
static_assert(WS_H + (size_t)T * D * 2 == WS_QK && WS_QK + (size_t)T * QKW * 2 == WS_VT && WS_VT + (size_t)VW * T * 2 == WS_Y && WS_Y + (size_t)T * YW * 2 == WS_PARK, "ws map");
static_assert((size_t)T * FF * 2 <= WS_Y - WS_QK, "ffh overlay");
constexpr int CW_BAR = 4096;
constexpr size_t CTL_ZERO_BYTES = 65536;
constexpr int LDS_BYTES = 147456, RING_BYTES = 131072, MISC_OFF = RING_BYTES;

struct Args { const void* in[18]; float* out; unsigned char* ws; };

__device__ __forceinline__ float wave_sum(float v) {
#pragma unroll
    for (int o = 1; o < 64; o <<= 1) v += __shfl_xor(v, o);
    return v;
}
__device__ __forceinline__ unsigned pk_bf16(float lo, float hi) { return pg8::cvt_pk_bf16(lo, hi); }

__device__ __forceinline__ void transpose_item(const float* W, int ldw, int K, int ncols, bf16_t* WT, LAS float* scr, int item, int lane, const float* kgain = nullptr) {
    const int nblk = ncols / 32, kb = item / nblk, nb = item % nblk, k0 = 64 * kb, n0 = 32 * nb;
#pragma unroll 8
    for (int i = 0; i < 32; ++i) { const int kk = 2 * i + (lane >> 5); scr[kk * 33 + (lane & 31)] = W[(size_t)(k0 + kk) * ldw + n0 + (lane & 31)] * (kgain ? kgain[k0 + kk] : 1.0f); }
    asm volatile("s_waitcnt lgkmcnt(0)" ::: "memory");
    const int c = lane & 7;
#pragma unroll
    for (int j = 0; j < 4; ++j) { const int n = (lane >> 3) + 8 * j; const LAS float* s = scr + (8 * c) * 33 + n;
        u32x4 o; o.x = pk_bf16(s[0 * 33], s[1 * 33]); o.y = pk_bf16(s[2 * 33], s[3 * 33]); o.z = pk_bf16(s[4 * 33], s[5 * 33]); o.w = pk_bf16(s[6 * 33], s[7 * 33]);
        *(u32x4*)(WT + (size_t)(n0 + n) * K + k0 + 8 * c) = o; }
    asm volatile("s_waitcnt lgkmcnt(0)" ::: "memory");
}
__device__ __forceinline__ void convert_weights(const Args& a, LAS unsigned char* lds, int gw, int NGW, int wave, int lane) {
    LAS float* scr = (LAS float*)(lds + wave * 16384);
    constexpr int I_IN = 9 * 256, I_G = 16 * 96, I_BR = 8 * 32, I_O = 16 * 32, I_1 = 16 * 128, I_2 = 64 * 32;
    constexpr int PER_LAYER = I_IN + I_G + 3 * I_BR + I_O + I_1 + I_2;
    for (int it = gw; it < DEPTH * PER_LAYER; it += NGW) {
        const int l = it / PER_LAYER; int r = it % PER_LAYER;
        unsigned char* wl = a.ws + WS_W + (size_t)l * W_LAYER;
        if (r < I_IN) { const int seg = r / 256, ri = r % 256, typ = seg % 3, grp = seg / 3;
            const float* W = (const float*)a.in[3] + (size_t)l * D * INW + seg * 512;
            bf16_t* dst = (typ == 2) ? (bf16_t*)(wl + WO_V) + (size_t)(512 * grp) * D : (bf16_t*)(wl + WO_QK) + (size_t)(1024 * grp + 512 * typ) * D;
            transpose_item(W, INW, D, 512, dst, scr, ri, lane); continue; }
        r -= I_IN;
        if (r < I_G) { transpose_item((const float*)a.in[11] + (size_t)l * D * 3072, 3072, D, 3072, (bf16_t*)(wl + WO_G), scr, r, lane); continue; }
        r -= I_G;
        if (r < 3 * I_BR) { const int br = r / I_BR, ri = r % I_BR; const float* W = (const float*)a.in[8 + br] + (size_t)l * 512 * D;
            transpose_item(W, D, 512, D, (bf16_t*)(wl + WO_BR) + (size_t)br * D * 512, scr, ri, lane); continue; }
        r -= 3 * I_BR;
        if (r < I_O) { transpose_item((const float*)a.in[13] + (size_t)l * D * D, D, D, D, (bf16_t*)(wl + WO_O), scr, r, lane); continue; }
        r -= I_O;
        if (r < I_1) { transpose_item((const float*)a.in[15] + (size_t)l * D * FF, FF, D, FF, (bf16_t*)(wl + WO_1), scr, r, lane, (const float*)a.in[14] + (size_t)l * D); continue; }
        r -= I_1;
        transpose_item((const float*)a.in[16] + (size_t)l * FF * D, D, FF, D, (bf16_t*)(wl + WO_2), scr, r, lane);
    }
}

__device__ __forceinline__ float log_sigmoid(float x) { return fminf(x, 0.f) - log1pf(expf(-fabsf(x))); }
template <int MODE>
__device__ __forceinline__ void rmsnorm_phase(const float* X, const float* gain, bf16_t* H, float* OutF, const float* w_in_l, const float* b_forget_l, float* F,
                                              LAS unsigned char* lds, int gw, int NGW, int tid, int lane) {
    LAS float* wfl = (LAS float*)lds;
    if (MODE == 1) {
#pragma unroll
        for (int e = 0; e < 16; ++e) { const int idx = tid + 512 * e, k = idx >> 3, j = idx & 7; wfl[j * 1024 + k] = w_in_l[(size_t)k * INW + 4608 + j]; }
        __syncthreads();
    }
    f32x4 g[4];
#pragma unroll
    for (int j = 0; j < 4; ++j) g[j] = *((const f32x4*)gain + lane + 64 * j);
    for (int m = gw; m < T; m += NGW) {
        const f32x4* xr = (const f32x4*)(X + (size_t)m * D) + lane;
        f32x4 v[4]; float s = 0.f;
#pragma unroll
        for (int j = 0; j < 4; ++j) { v[j] = xr[64 * j]; s += (v[j].x * v[j].x + v[j].y * v[j].y) + (v[j].z * v[j].z + v[j].w * v[j].w); }
        const float rstd = 1.0f / sqrtf(wave_sum(s) * (1.f / D) + EPS);
#pragma unroll
        for (int j = 0; j < 4; ++j) v[j] = v[j] * rstd * g[j];
        if (MODE == 2) {
            f32x4* o = (f32x4*)(OutF + (size_t)m * D) + lane;
#pragma unroll
            for (int j = 0; j < 4; ++j) o[64 * j] = v[j];
        } else {
            u32x2* o = (u32x2*)(H + (size_t)m * D) + lane;
#pragma unroll
            for (int j = 0; j < 4; ++j) { u32x2 w; w.x = pk_bf16(v[j].x, v[j].y); w.y = pk_bf16(v[j].z, v[j].w); o[64 * j] = w; }
        }
        if (MODE == 1) {
            float fa[8];
#pragma unroll
            for (int h = 0; h < 8; ++h) { float acc = 0.f;
#pragma unroll
                for (int j = 0; j < 4; ++j) { const f32x4 w = *(const LAS f32x4*)(wfl + h * 1024 + 4 * lane + 256 * j); acc += (v[j].x * w.x + v[j].y * w.y) + (v[j].z * w.z + v[j].w * w.w); }
                fa[h] = wave_sum(acc); }
            float mine = fa[0];
#pragma unroll
            for (int h = 1; h < 8; ++h) mine = (lane == h) ? fa[h] : mine;
            if (lane < 8) { const int b = m / S, s_ = m % S; F[((size_t)b * 8 + lane) * S + s_] = log_sigmoid(mine + b_forget_l[lane]); }
        }
    }
    if (MODE == 1) __syncthreads();
}
__device__ __forceinline__ void fcumsum(float* F, LAS unsigned char* lds, int tid, int lane, int wave) {
    LAS double* wt = (LAS double*)lds;
    for (int seq = blockIdx.x; seq < NB * 8; seq += gridDim.x) {
        f32x4* p = (f32x4*)(F + (size_t)seq * S + tid * 16);
        f32x4 v[4]; double c[16]; double run = 0.0;
#pragma unroll
        for (int j = 0; j < 4; ++j) { v[j] = p[j];
#pragma unroll
            for (int e = 0; e < 4; ++e) { run += (double)v[j][e]; c[4 * j + e] = run; } }
        double inc = run;
#pragma unroll
        for (int o = 1; o < 64; o <<= 1) { const double t = __shfl_up(inc, o); if (lane >= o) inc += t; }
        if (lane == 63) wt[wave] = inc;
        __syncthreads();
        double base = inc - run;
#pragma unroll
        for (int w = 0; w < 8; ++w) if (w < wave) base += wt[w];
#pragma unroll
        for (int j = 0; j < 4; ++j) { f32x4 o;
#pragma unroll
            for (int e = 0; e < 4; ++e) o[e] = (float)(base + c[4 * j + e]);
            p[j] = o; }
        __syncthreads();
    }
}
__device__ __forceinline__ void rope_table_phase(float* tab, const int* positions, int gw, int NGW, int lane) {
    const int i = lane & 7;
    const float invf = (i == 0) ? 1.0f : (i == 1) ? 0.19392274474868576f : (i == 2) ? 0.03760603093086393f : (i == 3) ? 0.007292664737217109f
                     : (i == 4) ? 0.001414213562373095f : (i == 5) ? 0.0002742481756762073f : (i == 6) ? 5.318295896944988e-05f : 1.031338537721246e-05f;
    for (int r8 = gw; r8 < T / 8; r8 += NGW) { const int row = r8 * 8 + (lane >> 3);
        float sn, cs; sincosf((float)positions[row] * invf, &sn, &cs);
        tab[(size_t)row * 16 + i] = cs; tab[(size_t)row * 16 + 8 + i] = sn; }
}
__device__ __forceinline__ void rope_phase(bf16_t* QK, const float* tab, int gw, int NGW, int lane) {
    for (int r4 = gw; r4 < T / 4; r4 += NGW) {
        const int row = r4 * 4 + (lane >> 4), j = lane & 15;
        const f32x4* tp = (const f32x4*)(tab + (size_t)row * 16);
        const f32x4 c0 = tp[0], c1 = tp[1], s0 = tp[2], s1 = tp[3];
        const float cs[8] = {c0.x, c0.y, c0.z, c0.w, c1.x, c1.y, c1.z, c1.w}, sn[8] = {s0.x, s0.y, s0.z, s0.w, s1.x, s1.y, s1.z, s1.w};
        bf16_t* p = QK + (size_t)row * QKW + 1024 + 64 * j;
        const u32x4 a = *(const u32x4*)p, b = *(const u32x4*)(p + 8);
        float x1[8], x2[8];
        x1[0] = pg8::bf_lo(a.x); x1[1] = pg8::bf_hi(a.x); x1[2] = pg8::bf_lo(a.y); x1[3] = pg8::bf_hi(a.y); x1[4] = pg8::bf_lo(a.z); x1[5] = pg8::bf_hi(a.z); x1[6] = pg8::bf_lo(a.w); x1[7] = pg8::bf_hi(a.w);
        x2[0] = pg8::bf_lo(b.x); x2[1] = pg8::bf_hi(b.x); x2[2] = pg8::bf_lo(b.y); x2[3] = pg8::bf_hi(b.y); x2[4] = pg8::bf_lo(b.z); x2[5] = pg8::bf_hi(b.z); x2[6] = pg8::bf_lo(b.w); x2[7] = pg8::bf_hi(b.w);
        float y1[8], y2[8];
#pragma unroll
        for (int i = 0; i < 8; ++i) { y1[i] = x1[i] * cs[i] - x2[i] * sn[i]; y2[i] = x2[i] * cs[i] + x1[i] * sn[i]; }
        u32x4 oa, ob;
        oa.x = pk_bf16(y1[0], y1[1]); oa.y = pk_bf16(y1[2], y1[3]); oa.z = pk_bf16(y1[4], y1[5]); oa.w = pk_bf16(y1[6], y1[7]);
        ob.x = pk_bf16(y2[0], y2[1]); ob.y = pk_bf16(y2[2], y2[3]); ob.z = pk_bf16(y2[4], y2[5]); ob.w = pk_bf16(y2[6], y2[7]);
        *(u32x4*)p = oa; *(u32x4*)(p + 8) = ob;
    }
}
__device__ __forceinline__ unsigned xb_xcc_id_early() { return (unsigned)__builtin_amdgcn_s_getreg((3 << 11) | 20) & 0xFu; }
namespace att {
constexpr int KSTR = 144, VSTR = 144;
constexpr int OFF_K = 0, OFF_V = 2 * 64 * KSTR  , OFF_FK = OFF_V + 2 * 128 * VSTR  , OFF_RB = OFF_FK + 512, OFF_END = OFF_RB + 1040;
static_assert(OFF_END <= RING_BYTES, "attention LDS");
__device__ __forceinline__ int crow(int r, int hi) { return (r & 3) + 8 * (r >> 2) + 4 * hi; }
__device__ __forceinline__ unsigned cvtpk(float lo, float hi) { return pg8::cvt_pk_bf16(lo, hi); }

template <int TYPE, int DV>
__device__ __forceinline__ void attn_pass(LAS unsigned char* lds, const bf16_t* QK, const bf16_t* VT, const float* Fbh, int tok0, int qcol, int kcol, int vrow,
                                          int q0, int t_lo, int t_hi, f32x16 (&o)[DV / 32]) {
    int tid_ = threadIdx.x; asm volatile("" : "+v"(tid_));
    const int tid = tid_, lane = tid & 63, r32 = lane & 31, hi = lane >> 5; const int wid = __builtin_amdgcn_readfirstlane(tid >> 6);
    const int q0w = q0 + 32 * wid, cw = q0w >> 6;
    bf16x8 qf[4];
    { const bf16_t* qp = QK + (size_t)(tok0 + q0w + r32) * QKW + qcol + 8 * hi;
#pragma unroll
      for (int d0 = 0; d0 < 4; ++d0) qf[d0] = *(const bf16x8*)(qp + 16 * d0); }
    float Fq = 0.f; if (TYPE == 2) Fq = Fbh[q0w + r32] * LOG2E;
#pragma unroll
    for (int db = 0; db < DV / 32; ++db)
#pragma unroll
        for (int r = 0; r < 16; ++r) o[db][r] = 0.f;
    float m_run = 0.f, l_run = 0.f;
    const int krow = tid >> 3, kch = tid & 7;
    const bf16_t* ksrc = QK + (size_t)(tok0 + krow) * QKW + kcol + 8 * kch;
    const bf16_t* vsrc = VT + (size_t)(vrow + krow) * T + tok0 + 8 * kch;
    const int kdst = OFF_K + krow * KSTR + kch * 16, vdst = OFF_V + krow * VSTR + (kch >> 1) * 32 + (kch & 1) * 8;
    u32x4 kreg, vreg0, vreg1; float freg = 0.f;
    vreg1 = (u32x4){0u, 0u, 0u, 0u};
#define ATT_LOAD(t) do { kreg = *(const u32x4*)(ksrc + (size_t)(t) * 64 * QKW); vreg0 = *(const u32x4*)(vsrc + (size_t)(t) * 64); \
        if (DV == 128) vreg1 = *(const u32x4*)(vsrc + (size_t)(t) * 64 + (size_t)64 * T); if (TYPE == 2) { if (tid < 64) freg = Fbh[(t) * 64 + tid] * LOG2E; } } while (0)
#define ATT_STORE(buf) do { *(LAS u32x4*)(lds + kdst + (buf) * 64 * KSTR) = kreg; \
        *(LAS u32x2*)(lds + vdst + (buf) * 128 * VSTR) = (u32x2){vreg0.x, vreg0.y}; *(LAS u32x2*)(lds + vdst + (buf) * 128 * VSTR + 16) = (u32x2){vreg0.z, vreg0.w}; \
        if (DV == 128) { *(LAS u32x2*)(lds + vdst + (buf) * 128 * VSTR + 64 * VSTR) = (u32x2){vreg1.x, vreg1.y}; *(LAS u32x2*)(lds + vdst + (buf) * 128 * VSTR + 64 * VSTR + 16) = (u32x2){vreg1.z, vreg1.w}; } \
        if (TYPE == 2) { if (tid < 64) *(LAS float*)(lds + OFF_FK + (buf) * 256 + tid * 4) = freg; } } while (0)
#define ATT_BAR() do { asm volatile("s_waitcnt lgkmcnt(0)" ::: "memory"); __builtin_amdgcn_s_barrier(); asm volatile("" ::: "memory"); } while (0)
    ATT_LOAD(t_lo); ATT_STORE(0);
    ATT_BAR();
    for (int t = t_lo; t <= t_hi; ++t) {
        const int buf = (t - t_lo) & 1;
        if (t < t_hi) ATT_LOAD(t + 1);
        bool part;
        if (TYPE == 0) part = (t >= cw - 8) && (t <= cw);
        else if (TYPE == 1) part = (t <= cw);
        else part = (64 * t <= q0w + 31);
        if (part) {
            const LAS unsigned char* Kb = lds + OFF_K + buf * 64 * KSTR;
            const LAS unsigned char* Vb = lds + OFF_V + buf * 128 * VSTR;
            bf16x8 kf[8];
#pragma unroll
            for (int kb = 0; kb < 2; ++kb)
#pragma unroll
                for (int d0 = 0; d0 < 4; ++d0) kf[kb * 4 + d0] = *(const LAS bf16x8*)(Kb + (32 * kb + r32) * KSTR + d0 * 32 + hi * 16);
            f32x16 p[2];
            if (TYPE == 0) {
                const LAS float* rb = (const LAS float*)(lds + OFF_RB);
                if (t <= cw - 3) { const float c0 = rb[0] - m_run;
#pragma unroll
                    for (int kb = 0; kb < 2; ++kb)
#pragma unroll
                        for (int r = 0; r < 16; ++r) p[kb][r] = c0;
                } else {
                    const int base = 64 * t - (q0w + r32) + 128;
#pragma unroll
                    for (int kb = 0; kb < 2; ++kb)
#pragma unroll
                        for (int r = 0; r < 16; ++r) { int idx = base + 32 * kb + crow(r, hi); idx = idx < 0 ? 0 : (idx > 256 ? 256 : idx); p[kb][r] = rb[idx] - m_run; }
                }
            } else if (TYPE == 2) {
                const LAS float* fk = (const LAS float*)(lds + OFF_FK + buf * 256);
                const float c0 = Fq - m_run;
#pragma unroll
                for (int kb = 0; kb < 2; ++kb)
#pragma unroll
                    for (int g = 0; g < 4; ++g) { const f32x4 f4 = *(const LAS f32x4*)(fk + 32 * kb + 8 * g + 4 * hi);
#pragma unroll
                        for (int e = 0; e < 4; ++e) p[kb][4 * g + e] = c0 - f4[e]; }
            } else {
                const float c0 = -m_run;
#pragma unroll
                for (int kb = 0; kb < 2; ++kb)
#pragma unroll
                    for (int r = 0; r < 16; ++r) p[kb][r] = c0;
            }
#pragma unroll
            for (int kb = 0; kb < 2; ++kb)
#pragma unroll
                for (int d0 = 0; d0 < 4; ++d0) p[kb] = __builtin_amdgcn_mfma_f32_32x32x16_bf16(kf[kb * 4 + d0], qf[d0], p[kb], 0, 0, 0);
            u32x4 vf[2][DV / 32];
#pragma unroll
            for (int j = 0; j < 2; ++j)
#pragma unroll
                for (int db = 0; db < DV / 32; ++db) vf[j][db] = *(const LAS u32x4*)(Vb + (32 * db + r32) * VSTR + 32 * j + 16 * hi);
            if (TYPE == 2) { if (64 * t + 63 > q0w) { const int qq = q0w + r32 - 64 * t;
#pragma unroll
                for (int kb = 0; kb < 2; ++kb)
#pragma unroll
                    for (int r = 0; r < 16; ++r) if (32 * kb + crow(r, hi) > qq) p[kb][r] = -INFINITY; } }
            float mx0 = fmaxf(fmaxf(p[0][0], p[0][1]), p[0][2]), mx1 = fmaxf(fmaxf(p[1][0], p[1][1]), p[1][2]);
#pragma unroll
            for (int r = 3; r < 15; r += 2) { mx0 = fmaxf(fmaxf(mx0, p[0][r]), p[0][r + 1]); mx1 = fmaxf(fmaxf(mx1, p[1][r]), p[1][r + 1]); }
            float mx = fmaxf(fmaxf(mx0, mx1), fmaxf(p[0][15], p[1][15]));
            mx = fmaxf(mx, __shfl_xor(mx, 32));
            if (__any(mx > 8.0f)) {
                const float dl = mx > 8.0f ? mx : 0.f, al = __builtin_amdgcn_exp2f(-dl);
                m_run += dl; l_run *= al;
#pragma unroll
                for (int db = 0; db < DV / 32; ++db)
#pragma unroll
                    for (int r = 0; r < 16; ++r) o[db][r] *= al;
#pragma unroll
                for (int kb = 0; kb < 2; ++kb)
#pragma unroll
                    for (int r = 0; r < 16; ++r) p[kb][r] -= dl;
            }
            float ls0 = 0.f, ls1 = 0.f;
#pragma unroll
            for (int r = 0; r < 16; ++r) { p[0][r] = __builtin_amdgcn_exp2f(p[0][r]); p[1][r] = __builtin_amdgcn_exp2f(p[1][r]); ls0 += p[0][r]; ls1 += p[1][r]; }
            l_run += ls0 + ls1;
            u32x4 vg[2][DV / 32];
#pragma unroll
            for (int j = 0; j < 2; ++j)
#pragma unroll
                for (int db = 0; db < DV / 32; ++db) vg[j][db] = *(const LAS u32x4*)(Vb + (32 * db + r32) * VSTR + 32 * (2 + j) + 16 * hi);
#pragma unroll
            for (int kb = 0; kb < 2; ++kb)
#pragma unroll
                for (int j = 0; j < 2; ++j) {
                    u32x4 pw; pw.x = cvtpk(p[kb][8 * j + 0], p[kb][8 * j + 1]); pw.y = cvtpk(p[kb][8 * j + 2], p[kb][8 * j + 3]); pw.z = cvtpk(p[kb][8 * j + 4], p[kb][8 * j + 5]); pw.w = cvtpk(p[kb][8 * j + 6], p[kb][8 * j + 7]);
                    const bf16x8 pf = __builtin_bit_cast(bf16x8, pw);
#pragma unroll
                    for (int db = 0; db < DV / 32; ++db) {
                        const u32x4 vw = (kb == 0) ? vf[j][db] : vg[j][db];
                        o[db] = __builtin_amdgcn_mfma_f32_32x32x16_bf16(__builtin_bit_cast(bf16x8, vw), pf, o[db], 0, 0, 0);
                    }
                }
        }
        if (t < t_hi) ATT_STORE(buf ^ 1);
        ATT_BAR();
    }
#undef ATT_BAR
#undef ATT_LOAD
#undef ATT_STORE
    l_run += __shfl_xor(l_run, 32);
    const float inv = 1.0f / l_run;
#pragma unroll
    for (int db = 0; db < DV / 32; ++db)
#pragma unroll
        for (int r = 0; r < 16; ++r) o[db][r] *= inv;
}
template <int NDB>
__device__ __forceinline__ void store_y(bf16_t* Y, const f32x16 (&o)[NDB], int tokrow, int ycol, int hi) {
    bf16_t* yp = Y + (size_t)tokrow * 512 + ycol + 4 * hi;
#pragma unroll
    for (int db = 0; db < NDB; ++db)
#pragma unroll
        for (int g = 0; g < 4; ++g) { u32x2 w; w.x = cvtpk(o[db][4 * g + 0], o[db][4 * g + 1]); w.y = cvtpk(o[db][4 * g + 2], o[db][4 * g + 3]); *(u32x2*)(yp + 32 * db + 8 * g) = w; }
}
__device__ __forceinline__ void attention_phase(const Args& a, LAS unsigned char* lds, int layer, unsigned* counter) {
    int tid_ = threadIdx.x; asm volatile("" : "+v"(tid_));
    const int tid = tid_, lane = tid & 63, r32 = lane & 31, hi = lane >> 5; const int wid = __builtin_amdgcn_readfirstlane(tid >> 6);
    const bf16_t* QK = (const bf16_t*)(a.ws + WS_QK); const bf16_t* VT = (const bf16_t*)(a.ws + WS_VT); bf16_t* Y = (bf16_t*)(a.ws + WS_Y);
    const float* F = (const float*)(a.ws + WS_F);
    float* park = (float*)(a.ws + WS_PARK) + (size_t)blockIdx.x * (64 * 512);
    volatile LAS int* s_unit = (volatile LAS int*)(lds + MISC_OFF);
    const float lam_init = 0.8f - 0.6f * expf(-0.3f * (float)layer);
    float lam;
    { const float* L = (const float*)a.in[5] + (size_t)layer * 256;
      const float s01 = wave_sum(L[lane] * L[64 + lane]), s23 = wave_sum(L[128 + lane] * L[192 + lane]);
      lam = expf(s01) - expf(s23) + lam_init; }
    const int myx = (int)(xb_xcc_id_early() & 7u);
    int qq = 0;
    for (;;) {
        const int xq = (myx + qq) & 7;
        if (tid == 0) *s_unit = (int)atomicAdd(counter + 16 * xq, 1u);
        __syncthreads();
        const int jq = *s_unit;
        __syncthreads();
        if (jq >= 640) { if (++qq == 8) break; continue; }
        int u;
        if (jq < 128) { const int qbi = jq >> 2, bh = xq + 8 * (jq & 3); u = qbi * 32 + bh; }
        else if (jq < 384) { const int i = jq - 128, qbi = i >> 3, bh = xq + 8 * (i & 7); u = 1024 + qbi * 64 + bh; }
        else { const int i = jq - 384, qbi = i >> 3, bh = xq + 8 * (i & 7); u = 3072 + qbi * 64 + bh; }
        if (u < 1024) {
            const int qb = 31 - (u >> 5), bh = u & 31, b = bh >> 2, h = bh & 3, tok0 = b * S, q0 = qb * 256;
            f32x16 o[4];
            attn_pass<1, 128>(lds, QK, VT, nullptr, tok0, 1024 + h * 128, 1536 + h * 128, 512 + h * 128, q0, 0, 4 * qb + 3, o);
            { f32x4* pk = (f32x4*)(park + (size_t)tid * 64);
#pragma unroll
              for (int db = 0; db < 4; ++db)
#pragma unroll
                for (int g = 0; g < 4; ++g) pk[db * 4 + g] = (f32x4){o[db][4 * g], o[db][4 * g + 1], o[db][4 * g + 2], o[db][4 * g + 3]}; }
            asm volatile("" ::: "memory");
            attn_pass<1, 128>(lds, QK, VT, nullptr, tok0, 1024 + h * 128 + 64, 1536 + h * 128 + 64, 512 + h * 128, q0, 0, 4 * qb + 3, o);
            float ssq = 0.f;
            { const f32x4* pk = (const f32x4*)(park + (size_t)tid * 64);
#pragma unroll
              for (int db = 0; db < 4; ++db)
#pragma unroll
                for (int g = 0; g < 4; ++g) { const f32x4 pv = pk[db * 4 + g];
#pragma unroll
                    for (int e = 0; e < 4; ++e) { const float v = pv[e] - lam * o[db][4 * g + e]; o[db][4 * g + e] = v; ssq += v * v; } } }
            ssq += __shfl_xor(ssq, 32);
            const float rs = (1.0f / sqrtf(ssq * (1.f / 128.f) + EPS)) * (1.0f - lam_init);
            const float* sg = (const float*)a.in[6] + (size_t)layer * 128;
#pragma unroll
            for (int db = 0; db < 4; ++db)
#pragma unroll
                for (int g = 0; g < 4; ++g) { const f32x4 gg = *(const f32x4*)(sg + 32 * db + 8 * g + 4 * hi);
#pragma unroll
                    for (int e = 0; e < 4; ++e) o[db][4 * g + e] *= rs * gg[e]; }
            store_y<4>(Y + (size_t)T * 512, o, tok0 + q0 + 32 * wid + r32, h * 128, hi);
        } else if (u < 3072) {
            const int i = u - 1024, qb = 31 - (i >> 6), bh = i & 63, b = bh >> 3, h = bh & 7, tok0 = b * S, q0 = qb * 256;
            f32x16 o[2];
            attn_pass<2, 64>(lds, QK, VT, F + (size_t)bh * S, tok0, 2048 + h * 64, 2560 + h * 64, 1024 + h * 64, q0, 0, 4 * qb + 3, o);
            store_y<2>(Y + (size_t)2 * T * 512, o, tok0 + q0 + 32 * wid + r32, h * 64, hi);
        } else {
            const int i = u - 3072, qb = i >> 6, bh = i & 63, b = bh >> 3, h = bh & 7, tok0 = b * S, q0 = qb * 256;
            LAS float* rb = (LAS float*)(lds + OFF_RB);
            if (tid < 257) rb[tid] = ((const float*)a.in[4])[((size_t)layer * 8 + h) * 257 + tid] * LOG2E;
            f32x16 o[2];
            const int t_lo = (4 * qb - 8) < 0 ? 0 : (4 * qb - 8);
            attn_pass<0, 64>(lds, QK, VT, nullptr, tok0, h * 64, 512 + h * 64, h * 64, q0, t_lo, 4 * qb + 3, o);
            store_y<2>(Y, o, tok0 + q0 + 32 * wid + r32, h * 64, hi);
        }
    }
}
}


#define XB_TMO      128
#define XB_XCNT(j)  (256  + 64 * (j))
#define XB_XSUB(j)  (1280 + 64 * (j))
#define XB_XGEN(j)  (2304 + 64 * (j))
#define XB_TOP      3328
#define XB_TOPGEN   3392
#define XCD_BAR_WORDS 3456
#define XB_SPIN_CAP (1u << 30)

__device__ __forceinline__ unsigned xb_ld(unsigned* p)              { return __hip_atomic_load(p, __ATOMIC_RELAXED, __HIP_MEMORY_SCOPE_AGENT); }
__device__ __forceinline__ unsigned xb_add(unsigned* p, unsigned v) { return __hip_atomic_fetch_add(p, v, __ATOMIC_RELAXED, __HIP_MEMORY_SCOPE_AGENT); }
__device__ __forceinline__ unsigned xb_xcc_id() { return (unsigned)__builtin_amdgcn_s_getreg((3 << 11) | 20) & 0xFu; }
#define XB_SPIN(cond, bar) do { unsigned _sp = 0; while (cond) { __builtin_amdgcn_s_sleep(1); \
    if ((++_sp & 255u) == 0u) { if (xb_ld(&(bar)[XB_TMO])) break; if (_sp > XB_SPIN_CAP) { atomicAdd(&(bar)[XB_TMO], 1u); break; } } } } while (0)

struct XcdBarrier {
    unsigned* bar; unsigned x;
    volatile LAS unsigned* st;
};

__device__ __forceinline__ XcdBarrier xcd_barrier_post(unsigned* bar, volatile LAS unsigned* st) {
    XcdBarrier b; b.bar = bar; b.x = xb_xcc_id(); b.st = st;
    if (threadIdx.x == 0) (void)xb_add(&bar[XB_XCNT(b.x)], 1u);
    return b;
}
__device__ __forceinline__ void xcd_barrier_complete(unsigned* bar, unsigned x, unsigned& nloc, unsigned& nx) {
    const unsigned G = gridDim.x * gridDim.y * gridDim.z;
    unsigned sum, cnt, mine, sp = 0u;
    for (;;) {
        sum = 0u; cnt = 0u; mine = 0u;
#pragma unroll
        for (unsigned j = 0; j < 16; ++j) { const unsigned c = xb_ld(&bar[XB_XCNT(j)]); sum += c; cnt += (c > 0u) ? 1u : 0u; mine = (j == x) ? c : mine; }
        if (sum == G) break;
        __builtin_amdgcn_s_sleep(1);
        if ((++sp & 255u) == 0u) { if (xb_ld(&bar[XB_TMO])) break; if (sp > XB_SPIN_CAP) { atomicAdd(&bar[XB_TMO], 1u); break; } }
    }
    nloc = mine > 0u ? mine : 1u; nx = cnt > 0u ? cnt : 1u;
}

__device__ __forceinline__ void xcd_barrier(const XcdBarrier& b) {
    asm volatile("s_waitcnt vmcnt(0)" ::: "memory");
    __syncthreads();
    if (threadIdx.x == 0) {
        unsigned* bar = b.bar;
        __builtin_amdgcn_s_waitcnt(0);
        unsigned nloc = b.st[0], nx = b.st[1];
        if (nloc == 0u) { xcd_barrier_complete(bar, b.x, nloc, nx); b.st[0] = nloc; b.st[1] = nx; }
        const unsigned old = xb_add(&bar[XB_XSUB(b.x)], 1u);
        const unsigned gen = old / nloc;
        if (old + 1u == (gen + 1u) * nloc) {
            __builtin_amdgcn_fence(__ATOMIC_RELEASE, "agent");
            asm volatile("s_waitcnt vmcnt(0)" ::: "memory");
            const unsigned og = xb_add(&bar[XB_TOP], 1u);
            const unsigned tg = og / nx;
            if (og + 1u == (tg + 1u) * nx) xb_add(&bar[XB_TOPGEN], 1u);
            else XB_SPIN(xb_ld(&bar[XB_TOPGEN]) == tg, bar);
            __builtin_amdgcn_fence(__ATOMIC_ACQUIRE, "agent");
            xb_add(&bar[XB_XGEN(b.x)], 1u);
            asm volatile("s_waitcnt vmcnt(0)" ::: "memory");
        } else {
            XB_SPIN(xb_ld(&bar[XB_XGEN(b.x)]) == gen, bar);
            __builtin_amdgcn_fence(__ATOMIC_ACQUIRE, "agent");
            asm volatile("s_waitcnt vmcnt(0)" ::: "memory");
        }
    }
    __syncthreads();
}

#define GEMM_CALL(EPI, A_, B_, M_, N_, K_, E_) do { pg8::Gemm g_{(const pg8::bf16_t*)(A_), (const pg8::bf16_t*)(B_), (M_), (N_), (K_)}; pg8::StaticOrder S_; S_.init((M_), (N_), (int)gridDim.x, (int)blockIdx.x); \
        pg8::gemm_phase<EPI, pg8::StaticOrder, true, true>(lds3, g_, S_, (E_)); } while (0)
typedef __attribute__((address_space(1))) unsigned char gu8_t;
__device__ __forceinline__ unsigned char* opaque_ptr(const void* p) { gu8_t* g = (gu8_t*)p; asm volatile("" : "+s"(g)); return (unsigned char*)g; }
#define WSB(off) (opaque_ptr(a.ws) + (off))
#define INF(i) ((const float*)opaque_ptr(a.in[i]))
#define GRID_BAR() do { XcdBarrier b_; b_.bar = (unsigned*)WSB(WS_CTL) + CW_BAR; b_.x = xb_xcc_id(); b_.st = (volatile LAS unsigned*)(lds3 + MISC_OFF) + 8; xcd_barrier(b_); } while (0)
__global__ void __launch_bounds__(512, 2) fwd_kernel(Args a) {
    extern __shared__ __attribute__((aligned(16))) unsigned char lds[];
    cg::grid_group grid = cg::this_grid();
    LAS unsigned char* lds3 = (LAS unsigned char*)lds;
    const int G = gridDim.x; const int bx = blockIdx.x;
    const int vcu = (G % 8 == 0) ? (bx % 8) * (G / 8) + bx / 8 : bx;
    const int NGW = G * 8;
    {
        const int tid = threadIdx.x, lane = tid & 63; const int wave = __builtin_amdgcn_readfirstlane(tid >> 6); const int gw = vcu * 8 + wave;
        if (tid < 64) ((LAS unsigned*)(lds3 + MISC_OFF))[tid] = 0u;
        __syncthreads();
        (void)xcd_barrier_post((unsigned*)WSB(WS_CTL) + CW_BAR, (volatile LAS unsigned*)(lds3 + MISC_OFF) + 8);
        grid.sync();
        convert_weights(a, lds3, gw, NGW, wave, lane);
        __syncthreads();
        rmsnorm_phase<1>(INF(0), INF(2), (bf16_t*)WSB(WS_H), nullptr, INF(3), INF(7), (float*)WSB(WS_F), lds3, gw, NGW, tid, lane);
        rope_table_phase((float*)WSB(WS_ROPE), (const int*)opaque_ptr(a.in[1]), gw, NGW, lane);
        GRID_BAR();
    }
#pragma unroll 1
    for (int l = 0; l < DEPTH; ++l) {
        int tid_ = threadIdx.x; asm volatile("" : "+v"(tid_));
        const int tid = tid_, lane = tid & 63; const int wave = __builtin_amdgcn_readfirstlane(tid >> 6); const int gw = vcu * 8 + wave;
        const size_t wlo = WS_W + (size_t)l * W_LAYER;
        fcumsum((float*)WSB(WS_F), lds3, tid, lane, wave);
        { pg8::EpiBf<1> E{(bf16_t*)WSB(WS_QK), (size_t)QKW, nullptr, C2}; GEMM_CALL(pg8::EpiBf<1>, WSB(WS_H), WSB(wlo + WO_QK), T, QKW, D, E); }
        { pg8::EpiBf<0> E{(bf16_t*)WSB(WS_VT), (size_t)T, nullptr, 1.f}; GEMM_CALL(pg8::EpiBf<0>, WSB(wlo + WO_V), WSB(WS_H), VW, T, D, E); }
        GRID_BAR();
        rope_phase((bf16_t*)WSB(WS_QK), (const float*)WSB(WS_ROPE), gw, NGW, lane);
        GRID_BAR();
        att::attention_phase(a, lds3, l, (unsigned*)WSB(WS_CTL) + 256 + 256 * l);
        GRID_BAR();
        { pg8::EpiBf<0> E{(bf16_t*)WSB(WS_G), (size_t)GW, nullptr, 1.f}; GEMM_CALL(pg8::EpiBf<0>, WSB(WS_H), WSB(wlo + WO_G), T, GW, D, E); }
        GRID_BAR();
        { pg8::EpiBranch<true> E{(bf16_t*)WSB(WS_MG), (const bf16_t*)WSB(WS_G), 0, INF(12) + (size_t)l * GW}; GEMM_CALL(pg8::EpiBranch<true>, WSB(WS_Y), WSB(wlo + WO_BR), T, D, 512, E); }
        { pg8::EpiBranch<false> E{(bf16_t*)WSB(WS_MG), (const bf16_t*)WSB(WS_G), 1024, INF(12) + (size_t)l * GW}; GEMM_CALL(pg8::EpiBranch<false>, WSB(WS_Y + (size_t)T * 512 * 2), WSB(wlo + WO_BR + (size_t)D * 512 * 2), T, D, 512, E); }
        { pg8::EpiBranch<false> E{(bf16_t*)WSB(WS_MG), (const bf16_t*)WSB(WS_G), 2048, INF(12) + (size_t)l * GW}; GEMM_CALL(pg8::EpiBranch<false>, WSB(WS_Y + (size_t)2 * T * 512 * 2), WSB(wlo + WO_BR + (size_t)2 * D * 512 * 2), T, D, 512, E); }
        GRID_BAR();
        { float* out = (float*)opaque_ptr(a.out); pg8::EpiResidN E{l == 0 ? INF(0) : (const float*)out, out, (bf16_t*)WSB(WS_H), (float*)WSB(WS_Y)}; GEMM_CALL(pg8::EpiResidN, WSB(WS_MG), WSB(wlo + WO_O), T, D, D, E); }
        GRID_BAR();
        {
          const float* sp = (const float*)WSB(WS_Y); float* rs2 = (float*)WSB(WS_Y + 4 * MiB);
          for (int row = (int)blockIdx.x * 512 + tid; row < T; row += (int)gridDim.x * 512) { const f32x4* q4 = (const f32x4*)(sp + (size_t)row * 16);
              const f32x4 a0 = q4[0], a1 = q4[1], a2 = q4[2], a3 = q4[3];
              const float ss = ((a0.x + a0.y) + (a0.z + a0.w)) + ((a1.x + a1.y) + (a1.z + a1.w)) + ((a2.x + a2.y) + (a2.z + a2.w)) + ((a3.x + a3.y) + (a3.z + a3.w));
              rs2[row] = 1.0f / (ss * (1.f / D) + EPS); } }
        GRID_BAR();
        { pg8::EpiBf<4> E{(bf16_t*)WSB(WS_FFH), (size_t)FF, (const float*)WSB(WS_Y + 4 * MiB), 1.f}; GEMM_CALL(pg8::EpiBf<4>, WSB(WS_H), WSB(wlo + WO_1), T, FF, D, E); }
        GRID_BAR();
        { float* out = (float*)opaque_ptr(a.out); pg8::EpiResid E{(const float*)out, out}; GEMM_CALL(pg8::EpiResid, WSB(WS_FFH), WSB(wlo + WO_2), T, D, FF, E); }
        GRID_BAR();
        { float* out = (float*)opaque_ptr(a.out);
          if (l + 1 < DEPTH) rmsnorm_phase<1>(out, INF(2) + (size_t)(l + 1) * D, (bf16_t*)WSB(WS_H), nullptr, INF(3) + (size_t)(l + 1) * D * INW, INF(7) + (size_t)(l + 1) * 8, (float*)WSB(WS_F), lds3, gw, NGW, tid, lane);
          else rmsnorm_phase<2>(out, INF(17), nullptr, out, nullptr, nullptr, nullptr, lds3, gw, NGW, tid, lane); }
        GRID_BAR();
    }
}

extern "C" void kernel_launch(void* const* d_in, const int* in_sizes, int n_in, void* d_out, int out_size, void* d_ws, size_t ws_size, hipStream_t stream) {
    static int grid = 0;
    if (grid == 0) {
        if (n_in != 18 || in_sizes[0] != T * D || out_size != T * D || ws_size < WS_END) { fprintf(stderr, "kernel_launch: unexpected shapes (n_in %d, in0 %d, out %d, ws %zu; need ws >= %zu)\n", n_in, n_in > 0 ? in_sizes[0] : -1, out_size, ws_size, (size_t)WS_END); grid = -1; return; }
        int dev = 0, cus = 0, per_cu = 0;
        if (hipGetDevice(&dev) != hipSuccess || hipDeviceGetAttribute(&cus, hipDeviceAttributeMultiprocessorCount, dev) != hipSuccess) { fprintf(stderr, "kernel_launch: device query failed\n"); grid = -1; return; }
        if (hipFuncSetAttribute((const void*)fwd_kernel, hipFuncAttributeMaxDynamicSharedMemorySize, LDS_BYTES) != hipSuccess) { fprintf(stderr, "kernel_launch: hipFuncSetAttribute failed\n"); grid = -1; return; }
        if (hipOccupancyMaxActiveBlocksPerMultiprocessor(&per_cu, (const void*)fwd_kernel, 512, LDS_BYTES) != hipSuccess || per_cu < 1) { fprintf(stderr, "kernel_launch: occupancy query says %d blocks per CU\n", per_cu); (void)hipGetLastError(); per_cu = 1; }
        grid = cus * 1;
    }
    if (grid < 0) return;
    if (hipMemsetAsync((char*)d_ws + WS_CTL, 0, CTL_ZERO_BYTES, stream) != hipSuccess) { fprintf(stderr, "kernel_launch: memset failed\n"); return; }
    Args a{};
    for (int i = 0; i < 18; ++i) a.in[i] = d_in[i];
    a.out = (float*)d_out; a.ws = (unsigned char*)d_ws;
    void* params[] = {&a};
    hipError_t e = hipLaunchCooperativeKernel((const void*)fwd_kernel, dim3(grid), dim3(512), params, LDS_BYTES, stream);
    if (e != hipSuccess) fprintf(stderr, "kernel_launch: cooperative launch failed: %s (grid %d)\n", hipGetErrorString(e), grid);
}
```

```cpp
#include <hip/hip_runtime.h>
#include <hip/hip_cooperative_groups.h>
#include <cstdio>
#include <cstdint>
#include <cmath>
namespace cg = cooperative_groups;
namespace pg8 {
#define PG8_LAS __attribute__((address_space(3)))
typedef unsigned short bf16_t;
typedef short bf16x8 __attribute__((ext_vector_type(8)));
typedef float f32x4 __attribute__((ext_vector_type(4)));
typedef unsigned u32x4 __attribute__((ext_vector_type(4)));
typedef unsigned u32x2v __attribute__((ext_vector_type(2)));
constexpr int BM = 256, BK = 64, HALF = 128, HTB = HALF * BK * 2  , STAGE_BYTES = 8 * HTB, NXCD = 8, WGM = 8;

__host__ __device__ __forceinline__ int lds_byte(int r, int c) { const int st = (r >> 4) * 2 + (c >> 5), rr = r & 15, cc = c & 31, ob = rr * 64 + cc * 2; return st * 1024 + (ob ^ (((ob >> 9) & 1) << 5)); }
__host__ __device__ __forceinline__ void stage_rc(int b, int& R, int& C) { const int st = b / 1024, sb = b % 1024, swz = sb ^ (((sb >> 9) & 1) << 5); R = (st >> 1) * 16 + swz / 64; C = (st & 1) * 32 + (swz % 64) / 2; }
__host__ __device__ __forceinline__ int perm32(int rho) { const int n = rho >> 4, i = rho & 15; return 8 * (i >> 2) + 4 * n + (i & 3); }

struct Unit { int pm, pn; };
struct Gemm { const bf16_t* A; const bf16_t* Bt; int M, N, K; };

struct StaticOrder {
    int nM, nN, nwg, G, c;
    __host__ __device__ void init(int M, int N, int G_, int c_) { nM = M / BM; nN = N / BM; nwg = nM * nN; G = G_; c = c_; }
    __host__ __device__ bool next(int i, Unit& u) const {
        const long L = (long)i * G + c; if (L >= nwg) return false;
        int wgid = (int)L; { const int q = nwg / NXCD, r = nwg % NXCD, xcd = wgid % NXCD, off = wgid / NXCD; wgid = (xcd < r ? xcd * (q + 1) : r * (q + 1) + (xcd - r) * q) + off; }
        const int nig = WGM * nN, gid = wgid / nig, fm = gid * WGM, gsz = (nM - fm) < WGM ? (nM - fm) : WGM;
        u.pm = fm + ((wgid % nig) % gsz); u.pn = (wgid % nig) / gsz; return true;
    }
    __device__ __forceinline__ void a_ready(const Unit&) const {}
    __device__ __forceinline__ void done(const Unit&) const {}
};

__device__ __forceinline__ unsigned cvt_pk_bf16(float lo, float hi) { unsigned r; asm volatile("v_cvt_pk_bf16_f32 %0, %1, %2" : "=v"(r) : "v"(lo), "v"(hi)); return r; }
template <class Epi, class Sched, bool ALIGN_EPI = false, bool SP2 = false>
__device__ __forceinline__ void gemm_phase(PG8_LAS unsigned char* lds, const Gemm g, const Sched& S, const Epi& E) {
    int tid_ = threadIdx.x; asm volatile("" : "+v"(tid_));
    const int tid = tid_, wid = __builtin_amdgcn_readfirstlane(tid >> 6), lane = tid & 63, wr = wid >> 2, wc = wid & 3, fr = lane & 15, fq = lane >> 4;
    const int K = g.K, nt = K / BK;
    unsigned voffA[2], voffB[2];
#pragma unroll
    for (int i = 0; i < 2; ++i) { int R, C; stage_rc(tid * 16 + i * 8192, R, C); const int Rb = Epi::PERM ? ((R & ~31) + perm32(R & 31)) : R;
        voffA[i] = (unsigned)(R * K + C) * 2u; voffB[i] = (unsigned)(Rb * K + C) * 2u; }
    const size_t kstep = (size_t)(BK * 2);
    const size_t hstep = (size_t)HALF * K * 2;
    const size_t tstep = 2 * hstep;
    const unsigned ldsw = (unsigned)wid * 1024u;
    const int aoff = lds_byte(wr * 64 + fr, fq * 8), boff = lds_byte(wc * 32 + fr, fq * 8);
#define PG8_SA(b, h) (((b) * 2 + (h)) * HTB)
#define PG8_SB(b, h) ((4 + (b) * 2 + (h)) * HTB)
#define PG8_STAGE(bufoff, gbase, voff) do { _Pragma("unroll") for (int _i = 0; _i < 2; ++_i) \
        __builtin_amdgcn_global_load_lds((const unsigned*)((const char*)(gbase) + (voff)[_i]), (PG8_LAS unsigned*)(lds + (bufoff) + ldsw + _i * 8192), 16, 0, 0); } while (0)
#define PG8_LDA(dst, b, h) do { _Pragma("unroll") for (int m = 0; m < 4; ++m) _Pragma("unroll") for (int k = 0; k < 2; ++k) dst[m][k] = *(const PG8_LAS bf16x8*)(lds + PG8_SA(b, h) + aoff + m * 2048 + k * 1024); } while (0)
#define PG8_LDB(dst, b, h) do { _Pragma("unroll") for (int n = 0; n < 2; ++n) _Pragma("unroll") for (int k = 0; k < 2; ++k) dst[n][k] = *(const PG8_LAS bf16x8*)(lds + PG8_SB(b, h) + boff + n * 2048 + k * 1024); } while (0)
#define PG8_MMA(ai, bj, At, Bt) do { __builtin_amdgcn_s_setprio(1); _Pragma("unroll") for (int m = 0; m < 4; ++m) _Pragma("unroll") for (int n = 0; n < 2; ++n) _Pragma("unroll") for (int k = 0; k < 2; ++k) \
        acc[ai][bj][m][n] = __builtin_amdgcn_mfma_f32_16x16x32_bf16(Bt[n][k], At[m][k], acc[ai][bj][m][n], 0, 0, 0); __builtin_amdgcn_s_setprio(0); } while (0)
#define PG8_WAIT_V(n) asm volatile("s_waitcnt vmcnt(" #n ")" ::: "memory")
#define PG8_WAIT_L(n) asm volatile("s_waitcnt lgkmcnt(" #n ")" ::: "memory")
#define PG8_BAR __builtin_amdgcn_s_barrier()
#define PG8_SCHED __builtin_amdgcn_sched_barrier(0)
    Unit cur, nxt; int ui = 0;
    if (!S.next(0, cur)) return;
    f32x4 acc[2][2][4][2];
#pragma unroll
    for (int a = 0; a < 2; ++a)
#pragma unroll
        for (int b = 0; b < 2; ++b)
#pragma unroll
            for (int m = 0; m < 4; ++m)
#pragma unroll
                for (int n = 0; n < 2; ++n) acc[a][b][m][n] = (f32x4){0.f, 0.f, 0.f, 0.f};
    bf16x8 At[4][2], B0[2][2], B1[2][2];
    const char* cA = (const char*)g.A + (size_t)cur.pm * tstep; const char* cB = (const char*)g.Bt + (size_t)cur.pn * tstep;
    S.a_ready(cur);
    if constexpr (SP2) {
        PG8_STAGE(PG8_SB(0, 0), cB, voffB); PG8_STAGE(PG8_SB(0, 1), cB + hstep, voffB); PG8_STAGE(PG8_SA(0, 0), cA, voffA); PG8_STAGE(PG8_SA(0, 1), cA + hstep, voffA);
        if (wr == 1) PG8_BAR;
        PG8_WAIT_V(2); PG8_BAR;
        PG8_STAGE(PG8_SB(1, 0), cB + kstep, voffB); PG8_STAGE(PG8_SA(1, 0), cA + kstep, voffA); PG8_STAGE(PG8_SB(1, 1), cB + hstep + kstep, voffB);
        PG8_WAIT_V(6); PG8_BAR;
    } else {
        PG8_STAGE(PG8_SB(0, 0), cB, voffB); PG8_STAGE(PG8_SA(0, 0), cA, voffA); PG8_STAGE(PG8_SB(0, 1), cB + hstep, voffB); PG8_STAGE(PG8_SA(0, 1), cA + hstep, voffA);
        if (wr == 1) PG8_BAR;
        PG8_WAIT_V(4); PG8_BAR;
        PG8_STAGE(PG8_SB(1, 0), cB + kstep, voffB); PG8_STAGE(PG8_SA(1, 0), cA + kstep, voffA); PG8_STAGE(PG8_SB(1, 1), cB + hstep + kstep, voffB);
        PG8_WAIT_V(6); PG8_BAR;
    }
    for (;;) {
        const bool has_next = S.next(ui + 1, nxt);
        const char* nA = has_next ? (const char*)g.A + (size_t)nxt.pm * tstep : cA; const char* nB = has_next ? (const char*)g.Bt + (size_t)nxt.pn * tstep : cB;
        for (int t = 0; t < nt; t += 2) {
            const bool last = (t == nt - 2);
            const char* a1 = cA + (size_t)(t + 1) * kstep;
            const char* a2 = last ? nA : cA + (size_t)(t + 2) * kstep; const char* b2 = last ? nB : cB + (size_t)(t + 2) * kstep;
            const char* a3 = a2 + kstep; const char* b3 = b2 + kstep;
            if (last && has_next) S.a_ready(nxt);
            if constexpr (SP2) {
            PG8_LDB(B0, 0, 0); PG8_LDB(B1, 0, 1); PG8_SCHED; PG8_LDA(At, 0, 0); PG8_STAGE(PG8_SA(1, 1), a1 + hstep, voffA);
            PG8_WAIT_V(8); PG8_WAIT_L(0); PG8_BAR; PG8_MMA(0, 0, At, B0); PG8_MMA(0, 1, At, B1); PG8_BAR; PG8_SCHED;
            PG8_LDA(At, 0, 1); PG8_STAGE(PG8_SB(0, 0), b2, voffB); PG8_STAGE(PG8_SB(0, 1), b2 + hstep, voffB); PG8_STAGE(PG8_SA(0, 0), a2, voffA);
            PG8_WAIT_V(8); PG8_WAIT_L(0); PG8_BAR; PG8_MMA(1, 0, At, B0); PG8_MMA(1, 1, At, B1); PG8_BAR; PG8_SCHED;
            PG8_LDB(B0, 1, 0); PG8_LDB(B1, 1, 1); PG8_SCHED; PG8_LDA(At, 1, 0); PG8_STAGE(PG8_SA(0, 1), a2 + hstep, voffA);
            PG8_WAIT_V(8); PG8_WAIT_L(0); PG8_BAR; PG8_MMA(0, 0, At, B0); PG8_MMA(0, 1, At, B1); PG8_BAR; PG8_SCHED;
            PG8_LDA(At, 1, 1); PG8_STAGE(PG8_SB(1, 0), b3, voffB); PG8_STAGE(PG8_SB(1, 1), b3 + hstep, voffB); PG8_STAGE(PG8_SA(1, 0), a3, voffA);
            PG8_WAIT_V(8); PG8_WAIT_L(0); PG8_BAR; PG8_MMA(1, 0, At, B0); PG8_MMA(1, 1, At, B1); PG8_BAR; PG8_SCHED;
            } else {
            PG8_LDB(B0, 0, 0); PG8_SCHED; PG8_LDA(At, 0, 0); PG8_STAGE(PG8_SA(1, 1), a1 + hstep, voffA);
            PG8_WAIT_L(8); PG8_BAR; PG8_WAIT_L(0); PG8_MMA(0, 0, At, B0); PG8_BAR; PG8_SCHED;
            PG8_LDB(B1, 0, 1); PG8_STAGE(PG8_SB(0, 0), b2, voffB);
            PG8_BAR; PG8_WAIT_L(0); PG8_MMA(0, 1, At, B1); PG8_BAR;
            PG8_LDA(At, 0, 1); PG8_STAGE(PG8_SA(0, 0), a2, voffA);
            PG8_BAR; PG8_WAIT_L(0); PG8_MMA(1, 0, At, B0); PG8_BAR; PG8_SCHED;
            PG8_STAGE(PG8_SB(0, 1), b2 + hstep, voffB);
            PG8_WAIT_V(6); PG8_BAR; PG8_MMA(1, 1, At, B1); PG8_BAR;
            PG8_LDB(B0, 1, 0); PG8_SCHED; PG8_LDA(At, 1, 0); PG8_STAGE(PG8_SA(0, 1), a2 + hstep, voffA);
            PG8_WAIT_L(8); PG8_BAR; PG8_WAIT_L(0); PG8_MMA(0, 0, At, B0); PG8_BAR; PG8_SCHED;
            PG8_LDB(B1, 1, 1); PG8_STAGE(PG8_SB(1, 0), b3, voffB);
            PG8_BAR; PG8_WAIT_L(0); PG8_MMA(0, 1, At, B1); PG8_BAR;
            PG8_LDA(At, 1, 1); PG8_STAGE(PG8_SA(1, 0), a3, voffA);
            PG8_BAR; PG8_WAIT_L(0); PG8_MMA(1, 0, At, B0); PG8_BAR; PG8_SCHED;
            PG8_STAGE(PG8_SB(1, 1), b3 + hstep, voffB);
            PG8_WAIT_V(6); PG8_BAR; PG8_MMA(1, 1, At, B1); PG8_BAR;
            }
        }
        if constexpr (ALIGN_EPI) { if (wr == 0) PG8_BAR; }
        if constexpr (!Epi::AFTER_DRAIN) { E(acc, cur, wr, wc, fr, fq); S.done(cur); }
        if (!has_next) break;
#pragma unroll
        for (int a = 0; a < 2; ++a)
#pragma unroll
            for (int b = 0; b < 2; ++b)
#pragma unroll
                for (int m = 0; m < 4; ++m)
#pragma unroll
                    for (int n = 0; n < 2; ++n) acc[a][b][m][n] = (f32x4){0.f, 0.f, 0.f, 0.f};
        cur = nxt; cA = nA; cB = nB; ++ui;
        if constexpr (ALIGN_EPI) { if (wr == 1) PG8_BAR; }
    }
    PG8_WAIT_V(0);
    if constexpr (!ALIGN_EPI) { if (wr == 0) PG8_BAR; }
    PG8_BAR;
    if constexpr (Epi::AFTER_DRAIN) { E.fused(acc, cur, wr, wc, fr, fq, lds, wid, lane); S.done(cur); }
#undef PG8_SA
#undef PG8_SB
#undef PG8_STAGE
#undef PG8_LDA
#undef PG8_LDB
#undef PG8_MMA
#undef PG8_WAIT_V
#undef PG8_WAIT_L
#undef PG8_BAR
#undef PG8_SCHED
}
}
namespace pg8 {
__device__ __forceinline__ float bf_lo(unsigned w) { return __uint_as_float(w << 16); }
__device__ __forceinline__ float bf_hi(unsigned w) { return __uint_as_float(w & 0xffff0000u); }
__device__ __forceinline__ u32x4 pack8(f32x4 v0, f32x4 v1) { u32x4 w; w.x = cvt_pk_bf16(v0[0], v0[1]); w.y = cvt_pk_bf16(v0[2], v0[3]); w.z = cvt_pk_bf16(v1[0], v1[1]); w.w = cvt_pk_bf16(v1[2], v1[3]); return w; }
template <int MODE> struct EpiBf {
    static constexpr bool PERM = true, AFTER_DRAIN = false;
    bf16_t* O; size_t ldc; const float* bias; float qscale;
    __device__ __forceinline__ void operator()(const f32x4 (&acc)[2][2][4][2], const Unit& u, int wr, int wc, int fr, int fq) const {
        const int row0 = u.pm * BM + wr * 64 + fr; const int col0 = u.pn * BM + wc * 32 + 8 * fq;
        float sc = 1.f; if (MODE == 1) { if (((u.pn >> 1) & 1) == 0) sc = qscale; }
        float rs[2][4];
#pragma unroll
        for (int ai = 0; ai < 2; ++ai)
#pragma unroll
            for (int m = 0; m < 4; ++m) rs[ai][m] = (MODE == 4) ? bias[row0 + ai * HALF + m * 16] : 1.f;
        f32x4 bv[2][2];
#pragma unroll
        for (int bj = 0; bj < 2; ++bj)
#pragma unroll
            for (int n = 0; n < 2; ++n) bv[bj][n] = (MODE == 2) ? *(const f32x4*)(bias + col0 + bj * HALF + 4 * n) : (f32x4){0.f, 0.f, 0.f, 0.f};
#pragma unroll
        for (int ai = 0; ai < 2; ++ai)
#pragma unroll
            for (int m = 0; m < 4; ++m) { bf16_t* rowp = O + (size_t)(row0 + ai * HALF + m * 16) * ldc + col0;
#pragma unroll
                for (int bj = 0; bj < 2; ++bj) { f32x4 v0 = acc[ai][bj][m][0], v1 = acc[ai][bj][m][1];
                    if (MODE == 1) { v0 = v0 * sc; v1 = v1 * sc; }
                    if (MODE == 2) { v0 = v0 + bv[bj][0]; v1 = v1 + bv[bj][1];
#pragma unroll
                        for (int e = 0; e < 4; ++e) { v0[e] = __builtin_amdgcn_rcpf(1.0f + __builtin_amdgcn_exp2f(-1.4426950408889634f * v0[e])); v1[e] = __builtin_amdgcn_rcpf(1.0f + __builtin_amdgcn_exp2f(-1.4426950408889634f * v1[e])); } }
                    if (MODE == 3) {
#pragma unroll
                        for (int e = 0; e < 4; ++e) { const float a0 = fmaxf(v0[e], 0.f), a1 = fmaxf(v1[e], 0.f); v0[e] = a0 * a0; v1[e] = a1 * a1; } }
                    if (MODE == 4) { const float r_ = rs[ai][m];
#pragma unroll
                        for (int e = 0; e < 4; ++e) { const float a0 = fmaxf(v0[e], 0.f), a1 = fmaxf(v1[e], 0.f); v0[e] = a0 * a0 * r_; v1[e] = a1 * a1 * r_; } }
                    *(u32x4*)(rowp + bj * HALF) = pack8(v0, v1); } }
    }
};
template <bool FIRST> struct EpiBranch {
    static constexpr bool PERM = true, AFTER_DRAIN = false;
    bf16_t* Mg; const bf16_t* G; int gcol0; const float* gbias;
    __device__ __forceinline__ void operator()(const f32x4 (&acc)[2][2][4][2], const Unit& u, int wr, int wc, int fr, int fq) const {
        const int row0 = u.pm * BM + wr * 64 + fr; const int col0 = u.pn * BM + wc * 32 + 8 * fq;
        f32x4 bb[2][2];
#pragma unroll
        for (int bj = 0; bj < 2; ++bj)
#pragma unroll
            for (int n = 0; n < 2; ++n) bb[bj][n] = *(const f32x4*)(gbias + gcol0 + col0 + bj * HALF + 4 * n);
#pragma unroll
        for (int ai = 0; ai < 2; ++ai) {
#pragma unroll
          for (int mp = 0; mp < 2; ++mp) {
            u32x4 gq[2][2], mo[2][2];
#pragma unroll
            for (int mi = 0; mi < 2; ++mi)
#pragma unroll
                for (int bj = 0; bj < 2; ++bj) { const size_t row = (size_t)(row0 + ai * HALF + (2 * mp + mi) * 16); const int col = col0 + bj * HALF;
                    gq[mi][bj] = *(const u32x4*)(G + row * 3072 + gcol0 + col);
                    if (!FIRST) mo[mi][bj] = *(const u32x4*)(Mg + row * 1024 + col); }
#pragma unroll
            for (int mi = 0; mi < 2; ++mi)
#pragma unroll
                for (int bj = 0; bj < 2; ++bj) { const int m = 2 * mp + mi; const size_t row = (size_t)(row0 + ai * HALF + m * 16); const int col = col0 + bj * HALF;
                    const u32x4 g = gq[mi][bj];
                    f32x4 g0 = (f32x4){bf_lo(g.x), bf_hi(g.x), bf_lo(g.y), bf_hi(g.y)} + bb[bj][0], g1 = (f32x4){bf_lo(g.z), bf_hi(g.z), bf_lo(g.w), bf_hi(g.w)} + bb[bj][1];
                    f32x4 v0 = acc[ai][bj][m][0], v1 = acc[ai][bj][m][1];
#pragma unroll
                    for (int e = 0; e < 4; ++e) { v0[e] *= __builtin_amdgcn_rcpf(1.0f + __builtin_amdgcn_exp2f(-1.4426950408889634f * g0[e])); v1[e] *= __builtin_amdgcn_rcpf(1.0f + __builtin_amdgcn_exp2f(-1.4426950408889634f * g1[e])); }
                    if (!FIRST) { const u32x4 o = mo[mi][bj];
                        v0[0] += bf_lo(o.x); v0[1] += bf_hi(o.x); v0[2] += bf_lo(o.y); v0[3] += bf_hi(o.y);
                        v1[0] += bf_lo(o.z); v1[1] += bf_hi(o.z); v1[2] += bf_lo(o.w); v1[3] += bf_hi(o.w); }
                    *(u32x4*)(Mg + row * 1024 + col) = pack8(v0, v1); }
          }
        }
    }
};
struct EpiResid {
    static constexpr bool PERM = false, AFTER_DRAIN = false;
    const float* base; float* out;
    __device__ __forceinline__ void operator()(const f32x4 (&acc)[2][2][4][2], const Unit& u, int wr, int wc, int fr, int fq) const {
        const int row0 = u.pm * BM + wr * 64 + fr; const int col0 = u.pn * BM + wc * 32 + 4 * fq;
#pragma unroll
        for (int ai = 0; ai < 2; ++ai) {
#pragma unroll
          for (int mp = 0; mp < 2; ++mp) {
            f32x4 bs[2][2][2];
#pragma unroll
            for (int mi = 0; mi < 2; ++mi) { const size_t off = (size_t)(row0 + ai * HALF + (2 * mp + mi) * 16) * 1024 + col0;
#pragma unroll
                for (int bj = 0; bj < 2; ++bj)
#pragma unroll
                    for (int n = 0; n < 2; ++n) bs[mi][bj][n] = *(const f32x4*)(base + off + bj * HALF + n * 16); }
#pragma unroll
            for (int mi = 0; mi < 2; ++mi) { const int m = 2 * mp + mi; const size_t off = (size_t)(row0 + ai * HALF + m * 16) * 1024 + col0;
#pragma unroll
                for (int bj = 0; bj < 2; ++bj)
#pragma unroll
                    for (int n = 0; n < 2; ++n) *(f32x4*)(out + off + bj * HALF + n * 16) = bs[mi][bj][n] + acc[ai][bj][m][n]; }
          }
        }
    }
};
struct EpiResidN {
    static constexpr bool PERM = false, AFTER_DRAIN = false;
    const float* base; float* out; bf16_t* xb; float* ssqp;
    __device__ __forceinline__ void operator()(const f32x4 (&acc)[2][2][4][2], const Unit& u, int wr, int wc, int fr, int fq) const {
        const int row0 = u.pm * BM + wr * 64 + fr; const int col0 = u.pn * BM + wc * 32 + 4 * fq;
#pragma unroll
        for (int ai = 0; ai < 2; ++ai) {
#pragma unroll
          for (int mp = 0; mp < 2; ++mp) {
            f32x4 bs[2][2][2];
#pragma unroll
            for (int mi = 0; mi < 2; ++mi) { const size_t off = (size_t)(row0 + ai * HALF + (2 * mp + mi) * 16) * 1024 + col0;
#pragma unroll
                for (int bj = 0; bj < 2; ++bj)
#pragma unroll
                    for (int n = 0; n < 2; ++n) bs[mi][bj][n] = *(const f32x4*)(base + off + bj * HALF + n * 16); }
#pragma unroll
            for (int mi = 0; mi < 2; ++mi) { const int m = 2 * mp + mi; const int row = row0 + ai * HALF + m * 16; const size_t off = (size_t)row * 1024 + col0;
                float sq = 0.f;
#pragma unroll
                for (int bj = 0; bj < 2; ++bj)
#pragma unroll
                    for (int n = 0; n < 2; ++n) { const f32x4 v = bs[mi][bj][n] + acc[ai][bj][m][n];
                        *(f32x4*)(out + off + bj * HALF + n * 16) = v;
                        u32x2v w; w.x = cvt_pk_bf16(v[0], v[1]); w.y = cvt_pk_bf16(v[2], v[3]); *(u32x2v*)(xb + off + bj * HALF + n * 16) = w;
                        sq += (v[0] * v[0] + v[1] * v[1]) + (v[2] * v[2] + v[3] * v[3]); }
                sq += __uint_as_float((unsigned)__builtin_amdgcn_ds_swizzle((int)__float_as_uint(sq), 0x401F));
                { auto rr = __builtin_amdgcn_permlane32_swap(__float_as_uint(sq), __float_as_uint(sq), false, false); sq = __uint_as_float(rr[0]) + __uint_as_float(rr[1]); }
                if (fq == 0) ssqp[(size_t)row * 16 + u.pn * 4 + wc] = sq; }
          }
        }
    }
};
}
#define LAS __attribute__((address_space(3)))
typedef unsigned short bf16_t;
typedef short bf16x8 __attribute__((ext_vector_type(8)));
typedef short s16x4 __attribute__((ext_vector_type(4)));
typedef float f32x4 __attribute__((ext_vector_type(4)));
typedef float f32x16 __attribute__((ext_vector_type(16)));
typedef unsigned u32x4 __attribute__((ext_vector_type(4)));
typedef unsigned u32x2 __attribute__((ext_vector_type(2)));
constexpr int NB = 8, S = 8192, D = 1024, T = NB * S, FF = 4096, INW = 4616, DEPTH = 2;
constexpr int QKW = 3072, VW = 1536, YW = 1536, GW = 3072;
constexpr float EPS = 1e-6f, LOG2E = 1.4426950408889634f, C2 = 0.125f * 1.4426950408889634f;
constexpr size_t MiB = 1u << 20;
constexpr size_t WS_CTL = 0, WS_W = 2 * MiB, W_LAYER = 36 * MiB;
constexpr size_t WO_QK = 0, WO_V = 6 * MiB, WO_G = 9 * MiB, WO_BR = 15 * MiB, WO_O = 18 * MiB, WO_1 = 20 * MiB, WO_2 = 28 * MiB;
constexpr size_t WS_F = 74 * MiB, WS_H = 76 * MiB, WS_QK = 204 * MiB, WS_VT = 588 * MiB, WS_Y = 780 * MiB, WS_PARK = 972 * MiB, WS_ROPE = 1004 * MiB  , WS_END = 1010 * MiB;
constexpr size_t WS_G = WS_QK, WS_MG = WS_VT, WS_FFH = WS_QK;
static_assert(WS_H + (size_t)T * D * 2 == WS_QK && WS_QK + (size_t)T * QKW * 2 == WS_VT && WS_VT + (size_t)VW * T * 2 == WS_Y && WS_Y + (size_t)T * YW * 2 == WS_PARK, "ws map");
static_assert((size_t)T * FF * 2 <= WS_Y - WS_QK, "ffh overlay");
constexpr int CW_BAR = 4096;
constexpr size_t CTL_ZERO_BYTES = 65536;
constexpr int LDS_BYTES = 147456, RING_BYTES = 131072, MISC_OFF = RING_BYTES;

struct Args { const void* in[18]; float* out; unsigned char* ws; };

#define DPP_ADD(v, ctrl) ((v) + __uint_as_float((unsigned)__builtin_amdgcn_update_dpp(0, (int)__float_as_uint(v), (ctrl), 0xF, 0xF, true)))
__device__ __forceinline__ float xor32_sum(float v) { auto rr = __builtin_amdgcn_permlane32_swap(__float_as_uint(v), __float_as_uint(v), false, false); return __uint_as_float(rr[0]) + __uint_as_float(rr[1]); }
__device__ __forceinline__ float xor32_max(float v) { auto rr = __builtin_amdgcn_permlane32_swap(__float_as_uint(v), __float_as_uint(v), false, false); return fmaxf(__uint_as_float(rr[0]), __uint_as_float(rr[1])); }
__device__ __forceinline__ float wave_sum(float v) {
    v = DPP_ADD(v, 0xB1); v = DPP_ADD(v, 0x4E); v = DPP_ADD(v, 0x141); v = DPP_ADD(v, 0x140);
    v += __uint_as_float((unsigned)__builtin_amdgcn_ds_swizzle((int)__float_as_uint(v), 0x401F));
    return xor32_sum(v);
}
__device__ __forceinline__ unsigned pk_bf16(float lo, float hi) { return pg8::cvt_pk_bf16(lo, hi); }

__device__ __forceinline__ void transpose_item(const float* W, int ldw, int K, int ncols, bf16_t* WT, LAS float* scr, int item, int lane, const float* kgain = nullptr) {
    const int nblk = ncols / 32, kb = item / nblk, nb = item % nblk, k0 = 64 * kb, n0 = 32 * nb;
    { f32x4 wv[8];
#pragma unroll
      for (int i = 0; i < 8; ++i) wv[i] = *(const f32x4*)(W + (size_t)(k0 + 8 * i + (lane >> 3)) * ldw + n0 + 4 * (lane & 7));
#pragma unroll
      for (int i = 0; i < 8; ++i) { const float kg = kgain ? kgain[k0 + 8 * i + (lane >> 3)] : 1.0f; LAS float* d = scr + (8 * i + (lane >> 3)) * 33 + 4 * (lane & 7);
          d[0] = wv[i].x * kg; d[1] = wv[i].y * kg; d[2] = wv[i].z * kg; d[3] = wv[i].w * kg; } }
    asm volatile("s_waitcnt lgkmcnt(0)" ::: "memory");
    const int c = lane & 7;
#pragma unroll
    for (int j = 0; j < 4; ++j) { const int n = (lane >> 3) + 8 * j; const LAS float* s = scr + (8 * c) * 33 + n;
        u32x4 o; o.x = pk_bf16(s[0 * 33], s[1 * 33]); o.y = pk_bf16(s[2 * 33], s[3 * 33]); o.z = pk_bf16(s[4 * 33], s[5 * 33]); o.w = pk_bf16(s[6 * 33], s[7 * 33]);
        *(u32x4*)(WT + (size_t)(n0 + n) * K + k0 + 8 * c) = o; }
    asm volatile("s_waitcnt lgkmcnt(0)" ::: "memory");
}
__device__ __forceinline__ void convert_weights(const Args& a, LAS unsigned char* lds, int gw, int NGW, int wave, int lane) {
    LAS float* scr = (LAS float*)(lds + wave * 16384);
    constexpr int I_IN = 9 * 256, I_G = 16 * 96, I_BR = 8 * 32, I_O = 16 * 32, I_1 = 16 * 128, I_2 = 64 * 32;
    constexpr int PER_LAYER = I_IN + I_G + 3 * I_BR + I_O + I_1 + I_2;
    for (int it = gw; it < DEPTH * PER_LAYER; it += NGW) {
        const int l = it / PER_LAYER; int r = it % PER_LAYER;
        unsigned char* wl = a.ws + WS_W + (size_t)l * W_LAYER;
        if (r < I_IN) { const int seg = r / 256, ri = r % 256, typ = seg % 3, grp = seg / 3;
            const float* W = (const float*)a.in[3] + (size_t)l * D * INW + seg * 512;
            bf16_t* dst = (typ == 2) ? (bf16_t*)(wl + WO_V) + (size_t)(512 * grp) * D : (bf16_t*)(wl + WO_QK) + (size_t)(1024 * grp + 512 * typ) * D;
            transpose_item(W, INW, D, 512, dst, scr, ri, lane); continue; }
        r -= I_IN;
        if (r < I_G) { transpose_item((const float*)a.in[11] + (size_t)l * D * 3072, 3072, D, 3072, (bf16_t*)(wl + WO_G), scr, r, lane); continue; }
        r -= I_G;
        if (r < 3 * I_BR) { const int br = r / I_BR, ri = r % I_BR; const float* W = (const float*)a.in[8 + br] + (size_t)l * 512 * D;
            transpose_item(W, D, 512, D, (bf16_t*)(wl + WO_BR) + (size_t)br * D * 512, scr, ri, lane); continue; }
        r -= 3 * I_BR;
        if (r < I_O) { transpose_item((const float*)a.in[13] + (size_t)l * D * D, D, D, D, (bf16_t*)(wl + WO_O), scr, r, lane); continue; }
        r -= I_O;
        if (r < I_1) { transpose_item((const float*)a.in[15] + (size_t)l * D * FF, FF, D, FF, (bf16_t*)(wl + WO_1), scr, r, lane, (const float*)a.in[14] + (size_t)l * D); continue; }
        r -= I_1;
        transpose_item((const float*)a.in[16] + (size_t)l * FF * D, D, FF, D, (bf16_t*)(wl + WO_2), scr, r, lane);
    }
}

__device__ __forceinline__ float log_sigmoid(float x) { return fminf(x, 0.f) - log1pf(expf(-fabsf(x))); }
template <int MODE>
__device__ __forceinline__ void rmsnorm_phase(const float* X, const float* gain, bf16_t* H, float* OutF, const float* w_in_l, const float* b_forget_l, float* F,
                                              LAS unsigned char* lds, int gw, int NGW, int tid, int lane) {
    LAS float* wfl = (LAS float*)lds;
    if (MODE == 1) {
#pragma unroll
        for (int e = 0; e < 16; ++e) { const int idx = tid + 512 * e, k = idx >> 3, j = idx & 7; wfl[j * 1024 + k] = w_in_l[(size_t)k * INW + 4608 + j]; }
        __syncthreads();
    }
    f32x4 g[4];
#pragma unroll
    for (int j = 0; j < 4; ++j) g[j] = *((const f32x4*)gain + lane + 64 * j);
    for (int m = gw; m < T; m += NGW) {
        const f32x4* xr = (const f32x4*)(X + (size_t)m * D) + lane;
        f32x4 v[4]; float s = 0.f;
#pragma unroll
        for (int j = 0; j < 4; ++j) { v[j] = xr[64 * j]; s += (v[j].x * v[j].x + v[j].y * v[j].y) + (v[j].z * v[j].z + v[j].w * v[j].w); }
        const float rstd = 1.0f / sqrtf(wave_sum(s) * (1.f / D) + EPS);
#pragma unroll
        for (int j = 0; j < 4; ++j) v[j] = v[j] * rstd * g[j];
        if (MODE == 2) {
            f32x4* o = (f32x4*)(OutF + (size_t)m * D) + lane;
#pragma unroll
            for (int j = 0; j < 4; ++j) o[64 * j] = v[j];
        } else {
            u32x2* o = (u32x2*)(H + (size_t)m * D) + lane;
#pragma unroll
            for (int j = 0; j < 4; ++j) { u32x2 w; w.x = pk_bf16(v[j].x, v[j].y); w.y = pk_bf16(v[j].z, v[j].w); o[64 * j] = w; }
        }
        if (MODE == 1) {
            float fa[8];
#pragma unroll
            for (int h = 0; h < 8; ++h) { float acc = 0.f;
#pragma unroll
                for (int j = 0; j < 4; ++j) { const f32x4 w = *(const LAS f32x4*)(wfl + h * 1024 + 4 * lane + 256 * j); acc += (v[j].x * w.x + v[j].y * w.y) + (v[j].z * w.z + v[j].w * w.w); }
                fa[h] = wave_sum(acc); }
            float mine = fa[0];
#pragma unroll
            for (int h = 1; h < 8; ++h) mine = (lane == h) ? fa[h] : mine;
            if (lane < 8) { const int b = m / S, s_ = m % S; F[((size_t)b * 8 + lane) * S + s_] = log_sigmoid(mine + b_forget_l[lane]); }
        }
    }
    if (MODE == 1) __syncthreads();
}
__device__ __forceinline__ void fcumsum(float* F, LAS unsigned char* lds, int tid, int lane, int wave) {
    LAS double* wt = (LAS double*)lds;
    for (int seq = blockIdx.x; seq < NB * 8; seq += gridDim.x) {
        f32x4* p = (f32x4*)(F + (size_t)seq * S + tid * 16);
        f32x4 v[4]; double c[16]; double run = 0.0;
#pragma unroll
        for (int j = 0; j < 4; ++j) { v[j] = p[j];
#pragma unroll
            for (int e = 0; e < 4; ++e) { run += (double)v[j][e]; c[4 * j + e] = run; } }
        double inc = run;
#pragma unroll
        for (int o = 1; o < 64; o <<= 1) { const double t = __shfl_up(inc, o); if (lane >= o) inc += t; }
        if (lane == 63) wt[wave] = inc;
        __syncthreads();
        double base = inc - run;
#pragma unroll
        for (int w = 0; w < 8; ++w) if (w < wave) base += wt[w];
#pragma unroll
        for (int j = 0; j < 4; ++j) { f32x4 o;
#pragma unroll
            for (int e = 0; e < 4; ++e) o[e] = (float)(base + c[4 * j + e]);
            p[j] = o; }
        __syncthreads();
    }
}
__device__ __forceinline__ void rope_table_phase(float* tab, const int* positions, int gw, int NGW, int lane) {
    const int i = lane & 7;
    const float invf = (i == 0) ? 1.0f : (i == 1) ? 0.19392274474868576f : (i == 2) ? 0.03760603093086393f : (i == 3) ? 0.007292664737217109f
                     : (i == 4) ? 0.001414213562373095f : (i == 5) ? 0.0002742481756762073f : (i == 6) ? 5.318295896944988e-05f : 1.031338537721246e-05f;
    for (int r8 = gw; r8 < T / 8; r8 += NGW) { const int row = r8 * 8 + (lane >> 3);
        float sn, cs; sincosf((float)positions[row] * invf, &sn, &cs);
        tab[(size_t)row * 16 + i] = cs; tab[(size_t)row * 16 + 8 + i] = sn; }
}
__device__ __forceinline__ void rope_phase(bf16_t* QK, const float* tab, int gw, int NGW, int lane) {
    for (int r4 = gw; r4 < T / 4; r4 += NGW) {
        const int row = r4 * 4 + (lane >> 4), j = lane & 15;
        const f32x4* tp = (const f32x4*)(tab + (size_t)row * 16);
        const f32x4 c0 = tp[0], c1 = tp[1], s0 = tp[2], s1 = tp[3];
        const float cs[8] = {c0.x, c0.y, c0.z, c0.w, c1.x, c1.y, c1.z, c1.w}, sn[8] = {s0.x, s0.y, s0.z, s0.w, s1.x, s1.y, s1.z, s1.w};
        bf16_t* p = QK + (size_t)row * QKW + 1024 + 64 * j;
        const u32x4 a = *(const u32x4*)p, b = *(const u32x4*)(p + 8);
        float x1[8], x2[8];
        x1[0] = pg8::bf_lo(a.x); x1[1] = pg8::bf_hi(a.x); x1[2] = pg8::bf_lo(a.y); x1[3] = pg8::bf_hi(a.y); x1[4] = pg8::bf_lo(a.z); x1[5] = pg8::bf_hi(a.z); x1[6] = pg8::bf_lo(a.w); x1[7] = pg8::bf_hi(a.w);
        x2[0] = pg8::bf_lo(b.x); x2[1] = pg8::bf_hi(b.x); x2[2] = pg8::bf_lo(b.y); x2[3] = pg8::bf_hi(b.y); x2[4] = pg8::bf_lo(b.z); x2[5] = pg8::bf_hi(b.z); x2[6] = pg8::bf_lo(b.w); x2[7] = pg8::bf_hi(b.w);
        float y1[8], y2[8];
#pragma unroll
        for (int i = 0; i < 8; ++i) { y1[i] = x1[i] * cs[i] - x2[i] * sn[i]; y2[i] = x2[i] * cs[i] + x1[i] * sn[i]; }
        u32x4 oa, ob;
        oa.x = pk_bf16(y1[0], y1[1]); oa.y = pk_bf16(y1[2], y1[3]); oa.z = pk_bf16(y1[4], y1[5]); oa.w = pk_bf16(y1[6], y1[7]);
        ob.x = pk_bf16(y2[0], y2[1]); ob.y = pk_bf16(y2[2], y2[3]); ob.z = pk_bf16(y2[4], y2[5]); ob.w = pk_bf16(y2[6], y2[7]);
        *(u32x4*)p = oa; *(u32x4*)(p + 8) = ob;
    }
}
__device__ __forceinline__ unsigned xb_xcc_id_early() { return (unsigned)__builtin_amdgcn_s_getreg((3 << 11) | 20) & 0xFu; }
namespace att {
constexpr int KSTR = 144, VSTR = 144;
constexpr int OFF_K = 0, OFF_V = 2 * 64 * KSTR  , OFF_FK = OFF_V + 2 * 128 * VSTR  , OFF_RB = OFF_FK + 512, OFF_END = OFF_RB + 1040;
static_assert(OFF_END <= RING_BYTES, "attention LDS");
__device__ __forceinline__ int crow(int r, int hi) { return (r & 3) + 8 * (r >> 2) + 4 * hi; }
__device__ __forceinline__ unsigned cvtpk(float lo, float hi) { return pg8::cvt_pk_bf16(lo, hi); }

template <int TYPE, int DV>
__device__ __forceinline__ void attn_pass(LAS unsigned char* lds, const bf16_t* QK, const bf16_t* VT, const float* Fbh, int tok0, int qcol, int kcol, int vrow,
                                          int q0, int t_lo, int t_hi, f32x16 (&o)[DV / 32]) {
    int tid_ = threadIdx.x; asm volatile("" : "+v"(tid_));
    const int tid = tid_, lane = tid & 63, r32 = lane & 31, hi = lane >> 5; const int wid = __builtin_amdgcn_readfirstlane(tid >> 6);
    const int q0w = q0 + 32 * wid, cw = q0w >> 6;
    bf16x8 qf[4];
    { const bf16_t* qp = QK + (size_t)(tok0 + q0w + r32) * QKW + qcol + 8 * hi;
#pragma unroll
      for (int d0 = 0; d0 < 4; ++d0) qf[d0] = *(const bf16x8*)(qp + 16 * d0); }
    float Fq = 0.f; if (TYPE == 2) Fq = Fbh[q0w + r32] * LOG2E;
#pragma unroll
    for (int db = 0; db < DV / 32; ++db)
#pragma unroll
        for (int r = 0; r < 16; ++r) o[db][r] = 0.f;
    float m_run = 0.f, l_run = 0.f;
    const int krow = tid >> 3, kch = tid & 7;
    const bf16_t* ksrc = QK + (size_t)(tok0 + krow) * QKW + kcol + 8 * kch;
    const bf16_t* vsrc = VT + (size_t)(vrow + krow) * T + tok0 + 8 * kch;
    const int kdst = OFF_K + krow * KSTR + kch * 16, vdst = OFF_V + krow * VSTR + (kch >> 1) * 32 + (kch & 1) * 8;
    u32x4 kreg, vreg0, vreg1; float freg = 0.f;
    vreg1 = (u32x4){0u, 0u, 0u, 0u};
#define ATT_LOAD(t) do { kreg = *(const u32x4*)(ksrc + (size_t)(t) * 64 * QKW); vreg0 = *(const u32x4*)(vsrc + (size_t)(t) * 64); \
        if (DV == 128) vreg1 = *(const u32x4*)(vsrc + (size_t)(t) * 64 + (size_t)64 * T); if (TYPE == 2) { if (tid < 64) freg = Fbh[(t) * 64 + tid] * LOG2E; } } while (0)
#define ATT_STORE(buf) do { *(LAS u32x4*)(lds + kdst + (buf) * 64 * KSTR) = kreg; \
        *(LAS u32x2*)(lds + vdst + (buf) * 128 * VSTR) = (u32x2){vreg0.x, vreg0.y}; *(LAS u32x2*)(lds + vdst + (buf) * 128 * VSTR + 16) = (u32x2){vreg0.z, vreg0.w}; \
        if (DV == 128) { *(LAS u32x2*)(lds + vdst + (buf) * 128 * VSTR + 64 * VSTR) = (u32x2){vreg1.x, vreg1.y}; *(LAS u32x2*)(lds + vdst + (buf) * 128 * VSTR + 64 * VSTR + 16) = (u32x2){vreg1.z, vreg1.w}; } \
        if (TYPE == 2) { if (tid < 64) *(LAS float*)(lds + OFF_FK + (buf) * 256 + tid * 4) = freg; } } while (0)
#define ATT_BAR() do { asm volatile("s_waitcnt lgkmcnt(0)" ::: "memory"); __builtin_amdgcn_s_barrier(); asm volatile("" ::: "memory"); } while (0)
    ATT_LOAD(t_lo); ATT_STORE(0);
    ATT_BAR();
    for (int t = t_lo; t <= t_hi; ++t) {
        const int buf = (t - t_lo) & 1;
        if (t < t_hi) ATT_LOAD(t + 1);
        bool part;
        if (TYPE == 0) part = (t >= cw - 8) && (t <= cw);
        else if (TYPE == 1) part = (t <= cw);
        else part = (64 * t <= q0w + 31);
        if (part) {
            const LAS unsigned char* Kb = lds + OFF_K + buf * 64 * KSTR;
            const LAS unsigned char* Vb = lds + OFF_V + buf * 128 * VSTR;
            bf16x8 kf[8];
#pragma unroll
            for (int kb = 0; kb < 2; ++kb)
#pragma unroll
                for (int d0 = 0; d0 < 4; ++d0) kf[kb * 4 + d0] = *(const LAS bf16x8*)(Kb + (32 * kb + r32) * KSTR + d0 * 32 + hi * 16);
            f32x16 p[2];
            if (TYPE == 0) {
                const LAS float* rb = (const LAS float*)(lds + OFF_RB);
                if (t <= cw - 3) { const float c0 = rb[0] - m_run;
#pragma unroll
                    for (int kb = 0; kb < 2; ++kb)
#pragma unroll
                        for (int r = 0; r < 16; ++r) p[kb][r] = c0;
                } else {
                    const int base = 64 * t - (q0w + r32) + 128;
#pragma unroll
                    for (int kb = 0; kb < 2; ++kb)
#pragma unroll
                        for (int r = 0; r < 16; ++r) { int idx = base + 32 * kb + crow(r, hi); idx = idx < 0 ? 0 : (idx > 256 ? 256 : idx); p[kb][r] = rb[idx] - m_run; }
                }
            } else if (TYPE == 2) {
                const LAS float* fk = (const LAS float*)(lds + OFF_FK + buf * 256);
                const float c0 = Fq - m_run;
#pragma unroll
                for (int kb = 0; kb < 2; ++kb)
#pragma unroll
                    for (int g = 0; g < 4; ++g) { const f32x4 f4 = *(const LAS f32x4*)(fk + 32 * kb + 8 * g + 4 * hi);
#pragma unroll
                        for (int e = 0; e < 4; ++e) p[kb][4 * g + e] = c0 - f4[e]; }
            } else {
                const float c0 = -m_run;
#pragma unroll
                for (int kb = 0; kb < 2; ++kb)
#pragma unroll
                    for (int r = 0; r < 16; ++r) p[kb][r] = c0;
            }
#pragma unroll
            for (int kb = 0; kb < 2; ++kb)
#pragma unroll
                for (int d0 = 0; d0 < 4; ++d0) p[kb] = __builtin_amdgcn_mfma_f32_32x32x16_bf16(kf[kb * 4 + d0], qf[d0], p[kb], 0, 0, 0);
            u32x4 vf[2][DV / 32];
#pragma unroll
            for (int j = 0; j < 2; ++j)
#pragma unroll
                for (int db = 0; db < DV / 32; ++db) vf[j][db] = *(const LAS u32x4*)(Vb + (32 * db + r32) * VSTR + 32 * j + 16 * hi);
            if (TYPE == 2) { if (64 * t + 63 > q0w) { const int qq = q0w + r32 - 64 * t;
#pragma unroll
                for (int kb = 0; kb < 2; ++kb)
#pragma unroll
                    for (int r = 0; r < 16; ++r) if (32 * kb + crow(r, hi) > qq) p[kb][r] = -INFINITY; } }
            float mx0 = fmaxf(fmaxf(p[0][0], p[0][1]), p[0][2]), mx1 = fmaxf(fmaxf(p[1][0], p[1][1]), p[1][2]);
#pragma unroll
            for (int r = 3; r < 15; r += 2) { mx0 = fmaxf(fmaxf(mx0, p[0][r]), p[0][r + 1]); mx1 = fmaxf(fmaxf(mx1, p[1][r]), p[1][r + 1]); }
            float mx = fmaxf(fmaxf(mx0, mx1), fmaxf(p[0][15], p[1][15]));
            mx = xor32_max(mx);
            if (__any(mx > 8.0f)) {
                const float dl = mx > 8.0f ? mx : 0.f, al = __builtin_amdgcn_exp2f(-dl);
                m_run += dl; l_run *= al;
#pragma unroll
                for (int db = 0; db < DV / 32; ++db)
#pragma unroll
                    for (int r = 0; r < 16; ++r) o[db][r] *= al;
#pragma unroll
                for (int kb = 0; kb < 2; ++kb)
#pragma unroll
                    for (int r = 0; r < 16; ++r) p[kb][r] -= dl;
            }
            float ls0 = 0.f, ls1 = 0.f;
#pragma unroll
            for (int r = 0; r < 16; ++r) { p[0][r] = __builtin_amdgcn_exp2f(p[0][r]); p[1][r] = __builtin_amdgcn_exp2f(p[1][r]); ls0 += p[0][r]; ls1 += p[1][r]; }
            l_run += ls0 + ls1;
            u32x4 vg[2][DV / 32];
#pragma unroll
            for (int j = 0; j < 2; ++j)
#pragma unroll
                for (int db = 0; db < DV / 32; ++db) vg[j][db] = *(const LAS u32x4*)(Vb + (32 * db + r32) * VSTR + 32 * (2 + j) + 16 * hi);
#pragma unroll
            for (int kb = 0; kb < 2; ++kb)
#pragma unroll
                for (int j = 0; j < 2; ++j) {
                    u32x4 pw; pw.x = cvtpk(p[kb][8 * j + 0], p[kb][8 * j + 1]); pw.y = cvtpk(p[kb][8 * j + 2], p[kb][8 * j + 3]); pw.z = cvtpk(p[kb][8 * j + 4], p[kb][8 * j + 5]); pw.w = cvtpk(p[kb][8 * j + 6], p[kb][8 * j + 7]);
                    const bf16x8 pf = __builtin_bit_cast(bf16x8, pw);
#pragma unroll
                    for (int db = 0; db < DV / 32; ++db) {
                        const u32x4 vw = (kb == 0) ? vf[j][db] : vg[j][db];
                        o[db] = __builtin_amdgcn_mfma_f32_32x32x16_bf16(__builtin_bit_cast(bf16x8, vw), pf, o[db], 0, 0, 0);
                    }
                }
        }
        if (t < t_hi) ATT_STORE(buf ^ 1);
        ATT_BAR();
    }
#undef ATT_BAR
#undef ATT_LOAD
#undef ATT_STORE
    l_run = xor32_sum(l_run);
    const float inv = 1.0f / l_run;
#pragma unroll
    for (int db = 0; db < DV / 32; ++db)
#pragma unroll
        for (int r = 0; r < 16; ++r) o[db][r] *= inv;
}
template <int NDB>
__device__ __forceinline__ void store_y(bf16_t* Y, const f32x16 (&o)[NDB], int tokrow, int ycol, int hi) {
    bf16_t* yp = Y + (size_t)tokrow * 512 + ycol + 4 * hi;
#pragma unroll
    for (int db = 0; db < NDB; ++db)
#pragma unroll
        for (int g = 0; g < 4; ++g) { u32x2 w; w.x = cvtpk(o[db][4 * g + 0], o[db][4 * g + 1]); w.y = cvtpk(o[db][4 * g + 2], o[db][4 * g + 3]); *(u32x2*)(yp + 32 * db + 8 * g) = w; }
}
__device__ __forceinline__ void attention_phase(const Args& a, LAS unsigned char* lds, int layer, unsigned* counter) {
    int tid_ = threadIdx.x; asm volatile("" : "+v"(tid_));
    const int tid = tid_, lane = tid & 63, r32 = lane & 31, hi = lane >> 5; const int wid = __builtin_amdgcn_readfirstlane(tid >> 6);
    const bf16_t* QK = (const bf16_t*)(a.ws + WS_QK); const bf16_t* VT = (const bf16_t*)(a.ws + WS_VT); bf16_t* Y = (bf16_t*)(a.ws + WS_Y);
    const float* F = (const float*)(a.ws + WS_F);
    float* park = (float*)(a.ws + WS_PARK) + (size_t)blockIdx.x * (64 * 512);
    volatile LAS int* s_unit = (volatile LAS int*)(lds + MISC_OFF);
    const float lam_init = 0.8f - 0.6f * expf(-0.3f * (float)layer);
    float lam;
    { const float* L = (const float*)a.in[5] + (size_t)layer * 256;
      const float s01 = wave_sum(L[lane] * L[64 + lane]), s23 = wave_sum(L[128 + lane] * L[192 + lane]);
      lam = expf(s01) - expf(s23) + lam_init; }
    const int myx = (int)(xb_xcc_id_early() & 7u);
    int qq = 0;
    for (;;) {
        const int xq = (myx + qq) & 7;
        if (tid == 0) *s_unit = (int)atomicAdd(counter + 16 * xq, 1u);
        __syncthreads();
        const int jq = *s_unit;
        __syncthreads();
        if (jq >= 640) { if (++qq == 8) break; continue; }
        int u;
        if (jq < 128) { const int qbi = jq >> 2, bh = xq + 8 * (jq & 3); u = qbi * 32 + bh; }
        else if (jq < 384) { const int i = jq - 128, qbi = i >> 3, bh = xq + 8 * (i & 7); u = 1024 + qbi * 64 + bh; }
        else { const int i = jq - 384, qbi = i >> 3, bh = xq + 8 * (i & 7); u = 3072 + qbi * 64 + bh; }
        if (u < 1024) {
            const int qb = 31 - (u >> 5), bh = u & 31, b = bh >> 2, h = bh & 3, tok0 = b * S, q0 = qb * 256;
            f32x16 o[4];
            attn_pass<1, 128>(lds, QK, VT, nullptr, tok0, 1024 + h * 128, 1536 + h * 128, 512 + h * 128, q0, 0, 4 * qb + 3, o);
            { f32x4* pk = (f32x4*)(park + (size_t)tid * 64);
#pragma unroll
              for (int db = 0; db < 4; ++db)
#pragma unroll
                for (int g = 0; g < 4; ++g) pk[db * 4 + g] = (f32x4){o[db][4 * g], o[db][4 * g + 1], o[db][4 * g + 2], o[db][4 * g + 3]}; }
            asm volatile("" ::: "memory");
            attn_pass<1, 128>(lds, QK, VT, nullptr, tok0, 1024 + h * 128 + 64, 1536 + h * 128 + 64, 512 + h * 128, q0, 0, 4 * qb + 3, o);
            float ssq = 0.f;
            { const f32x4* pk = (const f32x4*)(park + (size_t)tid * 64);
#pragma unroll
              for (int db = 0; db < 4; ++db)
#pragma unroll
                for (int g = 0; g < 4; ++g) { const f32x4 pv = pk[db * 4 + g];
#pragma unroll
                    for (int e = 0; e < 4; ++e) { const float v = pv[e] - lam * o[db][4 * g + e]; o[db][4 * g + e] = v; ssq += v * v; } } }
            ssq = xor32_sum(ssq);
            const float rs = (1.0f / sqrtf(ssq * (1.f / 128.f) + EPS)) * (1.0f - lam_init);
            const float* sg = (const float*)a.in[6] + (size_t)layer * 128;
#pragma unroll
            for (int db = 0; db < 4; ++db)
#pragma unroll
                for (int g = 0; g < 4; ++g) { const f32x4 gg = *(const f32x4*)(sg + 32 * db + 8 * g + 4 * hi);
#pragma unroll
                    for (int e = 0; e < 4; ++e) o[db][4 * g + e] *= rs * gg[e]; }
            store_y<4>(Y + (size_t)T * 512, o, tok0 + q0 + 32 * wid + r32, h * 128, hi);
        } else if (u < 3072) {
            const int i = u - 1024, qb = 31 - (i >> 6), bh = i & 63, b = bh >> 3, h = bh & 7, tok0 = b * S, q0 = qb * 256;
            f32x16 o[2];
            attn_pass<2, 64>(lds, QK, VT, F + (size_t)bh * S, tok0, 2048 + h * 64, 2560 + h * 64, 1024 + h * 64, q0, 0, 4 * qb + 3, o);
            store_y<2>(Y + (size_t)2 * T * 512, o, tok0 + q0 + 32 * wid + r32, h * 64, hi);
        } else {
            const int i = u - 3072, qb = i >> 6, bh = i & 63, b = bh >> 3, h = bh & 7, tok0 = b * S, q0 = qb * 256;
            LAS float* rb = (LAS float*)(lds + OFF_RB);
            if (tid < 257) rb[tid] = ((const float*)a.in[4])[((size_t)layer * 8 + h) * 257 + tid] * LOG2E;
            f32x16 o[2];
            const int t_lo = (4 * qb - 8) < 0 ? 0 : (4 * qb - 8);
            attn_pass<0, 64>(lds, QK, VT, nullptr, tok0, h * 64, 512 + h * 64, h * 64, q0, t_lo, 4 * qb + 3, o);
            store_y<2>(Y, o, tok0 + q0 + 32 * wid + r32, h * 64, hi);
        }
    }
}
}


#define XB_TMO      128
#define XB_XCNT(j)  (256  + 64 * (j))
#define XB_XSUB(j)  (1280 + 64 * (j))
#define XB_XGEN(j)  (2304 + 64 * (j))
#define XB_TOP      3328
#define XB_TOPGEN   3392
#define XCD_BAR_WORDS 3456
#define XB_SPIN_CAP (1u << 30)

__device__ __forceinline__ unsigned xb_ld(unsigned* p)              { return __hip_atomic_load(p, __ATOMIC_RELAXED, __HIP_MEMORY_SCOPE_AGENT); }
__device__ __forceinline__ unsigned xb_add(unsigned* p, unsigned v) { return __hip_atomic_fetch_add(p, v, __ATOMIC_RELAXED, __HIP_MEMORY_SCOPE_AGENT); }
__device__ __forceinline__ unsigned xb_xcc_id() { return (unsigned)__builtin_amdgcn_s_getreg((3 << 11) | 20) & 0xFu; }
#define XB_SPIN(cond, bar) do { unsigned _sp = 0; while (cond) { __builtin_amdgcn_s_sleep(1); \
    if ((++_sp & 255u) == 0u) { if (xb_ld(&(bar)[XB_TMO])) break; if (_sp > XB_SPIN_CAP) { atomicAdd(&(bar)[XB_TMO], 1u); break; } } } } while (0)

struct XcdBarrier {
    unsigned* bar; unsigned x;
    volatile LAS unsigned* st;
};

__device__ __forceinline__ XcdBarrier xcd_barrier_post(unsigned* bar, volatile LAS unsigned* st) {
    XcdBarrier b; b.bar = bar; b.x = xb_xcc_id(); b.st = st;
    if (threadIdx.x == 0) (void)xb_add(&bar[XB_XCNT(b.x)], 1u);
    return b;
}
__device__ __forceinline__ void xcd_barrier_complete(unsigned* bar, unsigned x, unsigned& nloc, unsigned& nx) {
    const unsigned G = gridDim.x * gridDim.y * gridDim.z;
    unsigned sum, cnt, mine, sp = 0u;
    for (;;) {
        sum = 0u; cnt = 0u; mine = 0u;
#pragma unroll
        for (unsigned j = 0; j < 16; ++j) { const unsigned c = xb_ld(&bar[XB_XCNT(j)]); sum += c; cnt += (c > 0u) ? 1u : 0u; mine = (j == x) ? c : mine; }
        if (sum == G) break;
        __builtin_amdgcn_s_sleep(1);
        if ((++sp & 255u) == 0u) { if (xb_ld(&bar[XB_TMO])) break; if (sp > XB_SPIN_CAP) { atomicAdd(&bar[XB_TMO], 1u); break; } }
    }
    nloc = mine > 0u ? mine : 1u; nx = cnt > 0u ? cnt : 1u;
}

__device__ __forceinline__ void xcd_barrier(const XcdBarrier& b) {
    asm volatile("s_waitcnt vmcnt(0)" ::: "memory");
    __syncthreads();
    if (threadIdx.x == 0) {
        unsigned* bar = b.bar;
        __builtin_amdgcn_s_waitcnt(0);
        unsigned nloc = b.st[0], nx = b.st[1];
        if (nloc == 0u) { xcd_barrier_complete(bar, b.x, nloc, nx); b.st[0] = nloc; b.st[1] = nx; }
        const unsigned old = xb_add(&bar[XB_XSUB(b.x)], 1u);
        const unsigned gen = old / nloc;
        if (old + 1u == (gen + 1u) * nloc) {
            __builtin_amdgcn_fence(__ATOMIC_RELEASE, "agent");
            asm volatile("s_waitcnt vmcnt(0)" ::: "memory");
            const unsigned og = xb_add(&bar[XB_TOP], 1u);
            const unsigned tg = og / nx;
            if (og + 1u == (tg + 1u) * nx) xb_add(&bar[XB_TOPGEN], 1u);
            else XB_SPIN(xb_ld(&bar[XB_TOPGEN]) == tg, bar);
            __builtin_amdgcn_fence(__ATOMIC_ACQUIRE, "agent");
            xb_add(&bar[XB_XGEN(b.x)], 1u);
            asm volatile("s_waitcnt vmcnt(0)" ::: "memory");
        } else {
            XB_SPIN(xb_ld(&bar[XB_XGEN(b.x)]) == gen, bar);
            __builtin_amdgcn_fence(__ATOMIC_ACQUIRE, "agent");
            asm volatile("s_waitcnt vmcnt(0)" ::: "memory");
        }
    }
    __syncthreads();
}

#define GEMM_CALL(EPI, A_, B_, M_, N_, K_, E_) do { pg8::Gemm g_{(const pg8::bf16_t*)(A_), (const pg8::bf16_t*)(B_), (M_), (N_), (K_)}; pg8::StaticOrder S_; S_.init((M_), (N_), (int)gridDim.x, (int)blockIdx.x); \
        pg8::gemm_phase<EPI, pg8::StaticOrder, true, true>(lds3, g_, S_, (E_)); } while (0)
typedef __attribute__((address_space(1))) unsigned char gu8_t;
__device__ __forceinline__ unsigned char* opaque_ptr(const void* p) { gu8_t* g = (gu8_t*)p; asm volatile("" : "+s"(g)); return (unsigned char*)g; }
#define WSB(off) (opaque_ptr(a.ws) + (off))
#define INF(i) ((const float*)opaque_ptr(a.in[i]))
#define GRID_BAR() do { XcdBarrier b_; b_.bar = (unsigned*)WSB(WS_CTL) + CW_BAR; b_.x = xb_xcc_id(); b_.st = (volatile LAS unsigned*)(lds3 + MISC_OFF) + 8; xcd_barrier(b_); } while (0)
__global__ void __launch_bounds__(512, 2) fwd_kernel(Args a) {
    extern __shared__ __attribute__((aligned(16))) unsigned char lds[];
    cg::grid_group grid = cg::this_grid();
    LAS unsigned char* lds3 = (LAS unsigned char*)lds;
    const int G = gridDim.x; const int bx = blockIdx.x;
    const int vcu = (G % 8 == 0) ? (bx % 8) * (G / 8) + bx / 8 : bx;
    const int NGW = G * 8;
    {
        const int tid = threadIdx.x, lane = tid & 63; const int wave = __builtin_amdgcn_readfirstlane(tid >> 6); const int gw = vcu * 8 + wave;
        if (tid < 64) ((LAS unsigned*)(lds3 + MISC_OFF))[tid] = 0u;
        __syncthreads();
        (void)xcd_barrier_post((unsigned*)WSB(WS_CTL) + CW_BAR, (volatile LAS unsigned*)(lds3 + MISC_OFF) + 8);
        grid.sync();
        convert_weights(a, lds3, gw, NGW, wave, lane);
        __syncthreads();
        rmsnorm_phase<1>(INF(0), INF(2), (bf16_t*)WSB(WS_H), nullptr, INF(3), INF(7), (float*)WSB(WS_F), lds3, gw, NGW, tid, lane);
        rope_table_phase((float*)WSB(WS_ROPE), (const int*)opaque_ptr(a.in[1]), gw, NGW, lane);
        GRID_BAR();
    }
#pragma unroll 1
    for (int l = 0; l < DEPTH; ++l) {
        int tid_ = threadIdx.x; asm volatile("" : "+v"(tid_));
        const int tid = tid_, lane = tid & 63; const int wave = __builtin_amdgcn_readfirstlane(tid >> 6); const int gw = vcu * 8 + wave;
        const size_t wlo = WS_W + (size_t)l * W_LAYER;
        fcumsum((float*)WSB(WS_F), lds3, tid, lane, wave);
        { pg8::EpiBf<1> E{(bf16_t*)WSB(WS_QK), (size_t)QKW, nullptr, C2}; GEMM_CALL(pg8::EpiBf<1>, WSB(WS_H), WSB(wlo + WO_QK), T, QKW, D, E); }
        { pg8::EpiBf<0> E{(bf16_t*)WSB(WS_VT), (size_t)T, nullptr, 1.f}; GEMM_CALL(pg8::EpiBf<0>, WSB(wlo + WO_V), WSB(WS_H), VW, T, D, E); }
        GRID_BAR();
        rope_phase((bf16_t*)WSB(WS_QK), (const float*)WSB(WS_ROPE), gw, NGW, lane);
        GRID_BAR();
        att::attention_phase(a, lds3, l, (unsigned*)WSB(WS_CTL) + 256 + 256 * l);
        GRID_BAR();
        { pg8::EpiBf<0> E{(bf16_t*)WSB(WS_G), (size_t)GW, nullptr, 1.f}; GEMM_CALL(pg8::EpiBf<0>, WSB(WS_H), WSB(wlo + WO_G), T, GW, D, E); }
        GRID_BAR();
        { pg8::EpiBranch<true> E{(bf16_t*)WSB(WS_MG), (const bf16_t*)WSB(WS_G), 0, INF(12) + (size_t)l * GW}; GEMM_CALL(pg8::EpiBranch<true>, WSB(WS_Y), WSB(wlo + WO_BR), T, D, 512, E); }
        { pg8::EpiBranch<false> E{(bf16_t*)WSB(WS_MG), (const bf16_t*)WSB(WS_G), 1024, INF(12) + (size_t)l * GW}; GEMM_CALL(pg8::EpiBranch<false>, WSB(WS_Y + (size_t)T * 512 * 2), WSB(wlo + WO_BR + (size_t)D * 512 * 2), T, D, 512, E); }
        { pg8::EpiBranch<false> E{(bf16_t*)WSB(WS_MG), (const bf16_t*)WSB(WS_G), 2048, INF(12) + (size_t)l * GW}; GEMM_CALL(pg8::EpiBranch<false>, WSB(WS_Y + (size_t)2 * T * 512 * 2), WSB(wlo + WO_BR + (size_t)2 * D * 512 * 2), T, D, 512, E); }
        GRID_BAR();
        { float* out = (float*)opaque_ptr(a.out); pg8::EpiResidN E{l == 0 ? INF(0) : (const float*)out, out, (bf16_t*)WSB(WS_H), (float*)WSB(WS_Y)}; GEMM_CALL(pg8::EpiResidN, WSB(WS_MG), WSB(wlo + WO_O), T, D, D, E); }
        GRID_BAR();
        {
          const float* sp = (const float*)WSB(WS_Y); float* rs2 = (float*)WSB(WS_Y + 4 * MiB);
          for (int row = (int)blockIdx.x * 512 + tid; row < T; row += (int)gridDim.x * 512) { const f32x4* q4 = (const f32x4*)(sp + (size_t)row * 16);
              const f32x4 a0 = q4[0], a1 = q4[1], a2 = q4[2], a3 = q4[3];
              const float ss = ((a0.x + a0.y) + (a0.z + a0.w)) + ((a1.x + a1.y) + (a1.z + a1.w)) + ((a2.x + a2.y) + (a2.z + a2.w)) + ((a3.x + a3.y) + (a3.z + a3.w));
              rs2[row] = 1.0f / (ss * (1.f / D) + EPS); } }
        GRID_BAR();
        { pg8::EpiBf<4> E{(bf16_t*)WSB(WS_FFH), (size_t)FF, (const float*)WSB(WS_Y + 4 * MiB), 1.f}; GEMM_CALL(pg8::EpiBf<4>, WSB(WS_H), WSB(wlo + WO_1), T, FF, D, E); }
        GRID_BAR();
        { float* out = (float*)opaque_ptr(a.out); pg8::EpiResid E{(const float*)out, out}; GEMM_CALL(pg8::EpiResid, WSB(WS_FFH), WSB(wlo + WO_2), T, D, FF, E); }
        GRID_BAR();
        { float* out = (float*)opaque_ptr(a.out);
          if (l + 1 < DEPTH) rmsnorm_phase<1>(out, INF(2) + (size_t)(l + 1) * D, (bf16_t*)WSB(WS_H), nullptr, INF(3) + (size_t)(l + 1) * D * INW, INF(7) + (size_t)(l + 1) * 8, (float*)WSB(WS_F), lds3, gw, NGW, tid, lane);
          else rmsnorm_phase<2>(out, INF(17), nullptr, out, nullptr, nullptr, nullptr, lds3, gw, NGW, tid, lane); }
        GRID_BAR();
    }
}

extern "C" void kernel_launch(void* const* d_in, const int* in_sizes, int n_in, void* d_out, int out_size, void* d_ws, size_t ws_size, hipStream_t stream) {
    static int grid = 0;
    if (grid == 0) {
        if (n_in != 18 || in_sizes[0] != T * D || out_size != T * D || ws_size < WS_END) { fprintf(stderr, "kernel_launch: unexpected shapes (n_in %d, in0 %d, out %d, ws %zu; need ws >= %zu)\n", n_in, n_in > 0 ? in_sizes[0] : -1, out_size, ws_size, (size_t)WS_END); grid = -1; return; }
        int dev = 0, cus = 0, per_cu = 0;
        if (hipGetDevice(&dev) != hipSuccess || hipDeviceGetAttribute(&cus, hipDeviceAttributeMultiprocessorCount, dev) != hipSuccess) { fprintf(stderr, "kernel_launch: device query failed\n"); grid = -1; return; }
        if (hipFuncSetAttribute((const void*)fwd_kernel, hipFuncAttributeMaxDynamicSharedMemorySize, LDS_BYTES) != hipSuccess) { fprintf(stderr, "kernel_launch: hipFuncSetAttribute failed\n"); grid = -1; return; }
        if (hipOccupancyMaxActiveBlocksPerMultiprocessor(&per_cu, (const void*)fwd_kernel, 512, LDS_BYTES) != hipSuccess || per_cu < 1) { fprintf(stderr, "kernel_launch: occupancy query says %d blocks per CU\n", per_cu); (void)hipGetLastError(); per_cu = 1; }
        grid = cus * 1;
    }
    if (grid < 0) return;
    if (hipMemsetAsync((char*)d_ws + WS_CTL, 0, CTL_ZERO_BYTES, stream) != hipSuccess) { fprintf(stderr, "kernel_launch: memset failed\n"); return; }
    Args a{};
    for (int i = 0; i < 18; ++i) a.in[i] = d_in[i];
    a.out = (float*)d_out; a.ws = (unsigned char*)d_ws;
    void* params[] = {&a};
    hipError_t e = hipLaunchCooperativeKernel((const void*)fwd_kernel, dim3(grid), dim3(512), params, LDS_BYTES, stream);
    if (e != hipSuccess) fprintf(stderr, "kernel_launch: cooperative launch failed: %s (grid %d)\n", hipGetErrorString(e), grid);
}
```

```cpp
#include <hip/hip_runtime.h>
#include <hip/hip_cooperative_groups.h>
#include <cstdio>
#include <cstdint>
#include <cmath>
namespace cg = cooperative_groups;
namespace pg8 {
#define PG8_LAS __attribute__((address_space(3)))
typedef unsigned short bf16_t;
typedef short bf16x8 __attribute__((ext_vector_type(8)));
typedef float f32x4 __attribute__((ext_vector_type(4)));
typedef unsigned u32x4 __attribute__((ext_vector_type(4)));
typedef unsigned u32x2v __attribute__((ext_vector_type(2)));
constexpr int BM = 256, BK = 64, HALF = 128, HTB = HALF * BK * 2  , STAGE_BYTES = 8 * HTB, NXCD = 8, WGM = 8;

__host__ __device__ __forceinline__ int lds_byte(int r, int c) { const int st = (r >> 4) * 2 + (c >> 5), rr = r & 15, cc = c & 31, ob = rr * 64 + cc * 2; return st * 1024 + (ob ^ (((ob >> 9) & 1) << 5)); }
__host__ __device__ __forceinline__ void stage_rc(int b, int& R, int& C) { const int st = b / 1024, sb = b % 1024, swz = sb ^ (((sb >> 9) & 1) << 5); R = (st >> 1) * 16 + swz / 64; C = (st & 1) * 32 + (swz % 64) / 2; }
__host__ __device__ __forceinline__ int perm32(int rho) { const int n = rho >> 4, i = rho & 15; return 8 * (i >> 2) + 4 * n + (i & 3); }

struct Unit { int pm, pn; };
struct Gemm { const bf16_t* A; const bf16_t* Bt; int M, N, K; };

struct StaticOrder {
    int nM, nN, nwg, G, c;
    __host__ __device__ void init(int M, int N, int G_, int c_) { nM = M / BM; nN = N / BM; nwg = nM * nN; G = G_; c = c_; }
    __host__ __device__ bool next(int i, Unit& u) const {
        const long L = (long)i * G + c; if (L >= nwg) return false;
        int wgid = (int)L; { const int q = nwg / NXCD, r = nwg % NXCD, xcd = wgid % NXCD, off = wgid / NXCD; wgid = (xcd < r ? xcd * (q + 1) : r * (q + 1) + (xcd - r) * q) + off; }
        const int nig = WGM * nN, gid = wgid / nig, fm = gid * WGM, gsz = (nM - fm) < WGM ? (nM - fm) : WGM;
        u.pm = fm + ((wgid % nig) % gsz); u.pn = (wgid % nig) / gsz; return true;
    }
    __device__ __forceinline__ void a_ready(const Unit&) const {}
    __device__ __forceinline__ void done(const Unit&) const {}
};

__device__ __forceinline__ unsigned cvt_pk_bf16(float lo, float hi) { unsigned r; asm volatile("v_cvt_pk_bf16_f32 %0, %1, %2" : "=v"(r) : "v"(lo), "v"(hi)); return r; }
template <class Epi, class Sched, bool ALIGN_EPI = false, bool SP2 = false>
__device__ __forceinline__ void gemm_phase(PG8_LAS unsigned char* lds, const Gemm g, const Sched& S, const Epi& E) {
    int tid_ = threadIdx.x; asm volatile("" : "+v"(tid_));
    const int tid = tid_, wid = __builtin_amdgcn_readfirstlane(tid >> 6), lane = tid & 63, wr = wid >> 2, wc = wid & 3, fr = lane & 15, fq = lane >> 4;
    const int K = g.K, nt = K / BK;
    unsigned voffA[2], voffB[2];
#pragma unroll
    for (int i = 0; i < 2; ++i) { int R, C; stage_rc(tid * 16 + i * 8192, R, C); const int Rb = Epi::PERM ? ((R & ~31) + perm32(R & 31)) : R;
        voffA[i] = (unsigned)(R * K + C) * 2u; voffB[i] = (unsigned)(Rb * K + C) * 2u; }
    const size_t kstep = (size_t)(BK * 2);
    const size_t hstep = (size_t)HALF * K * 2;
    const size_t tstep = 2 * hstep;
    const unsigned ldsw = (unsigned)wid * 1024u;
    const int aoff = lds_byte(wr * 64 + fr, fq * 8), boff = lds_byte(wc * 32 + fr, fq * 8);
#define PG8_SA(b, h) (((b) * 2 + (h)) * HTB)
#define PG8_SB(b, h) ((4 + (b) * 2 + (h)) * HTB)
#define PG8_STAGE(bufoff, gbase, voff) do { _Pragma("unroll") for (int _i = 0; _i < 2; ++_i) \
        __builtin_amdgcn_global_load_lds((const unsigned*)((const char*)(gbase) + (voff)[_i]), (PG8_LAS unsigned*)(lds + (bufoff) + ldsw + _i * 8192), 16, 0, 0); } while (0)
#define PG8_LDA(dst, b, h) do { _Pragma("unroll") for (int m = 0; m < 4; ++m) _Pragma("unroll") for (int k = 0; k < 2; ++k) dst[m][k] = *(const PG8_LAS bf16x8*)(lds + PG8_SA(b, h) + aoff + m * 2048 + k * 1024); } while (0)
#define PG8_LDB(dst, b, h) do { _Pragma("unroll") for (int n = 0; n < 2; ++n) _Pragma("unroll") for (int k = 0; k < 2; ++k) dst[n][k] = *(const PG8_LAS bf16x8*)(lds + PG8_SB(b, h) + boff + n * 2048 + k * 1024); } while (0)
#define PG8_MMA(ai, bj, At, Bt) do { __builtin_amdgcn_s_setprio(1); _Pragma("unroll") for (int m = 0; m < 4; ++m) _Pragma("unroll") for (int n = 0; n < 2; ++n) _Pragma("unroll") for (int k = 0; k < 2; ++k) \
        acc[ai][bj][m][n] = __builtin_amdgcn_mfma_f32_16x16x32_bf16(Bt[n][k], At[m][k], acc[ai][bj][m][n], 0, 0, 0); __builtin_amdgcn_s_setprio(0); } while (0)
#define PG8_WAIT_V(n) asm volatile("s_waitcnt vmcnt(" #n ")" ::: "memory")
#define PG8_WAIT_L(n) asm volatile("s_waitcnt lgkmcnt(" #n ")" ::: "memory")
#define PG8_BAR __builtin_amdgcn_s_barrier()
#define PG8_SCHED __builtin_amdgcn_sched_barrier(0)
    Unit cur, nxt; int ui = 0;
    if (!S.next(0, cur)) return;
    f32x4 acc[2][2][4][2];
#pragma unroll
    for (int a = 0; a < 2; ++a)
#pragma unroll
        for (int b = 0; b < 2; ++b)
#pragma unroll
            for (int m = 0; m < 4; ++m)
#pragma unroll
                for (int n = 0; n < 2; ++n) acc[a][b][m][n] = (f32x4){0.f, 0.f, 0.f, 0.f};
    bf16x8 At[4][2], B0[2][2], B1[2][2];
    const char* cA = (const char*)g.A + (size_t)cur.pm * tstep; const char* cB = (const char*)g.Bt + (size_t)cur.pn * tstep;
    S.a_ready(cur);
    if constexpr (SP2) {
        PG8_STAGE(PG8_SB(0, 0), cB, voffB); PG8_STAGE(PG8_SB(0, 1), cB + hstep, voffB); PG8_STAGE(PG8_SA(0, 0), cA, voffA); PG8_STAGE(PG8_SA(0, 1), cA + hstep, voffA);
        if (wr == 1) PG8_BAR;
        PG8_WAIT_V(2); PG8_BAR;
        PG8_STAGE(PG8_SB(1, 0), cB + kstep, voffB); PG8_STAGE(PG8_SA(1, 0), cA + kstep, voffA); PG8_STAGE(PG8_SB(1, 1), cB + hstep + kstep, voffB);
        PG8_WAIT_V(6); PG8_BAR;
    } else {
        PG8_STAGE(PG8_SB(0, 0), cB, voffB); PG8_STAGE(PG8_SA(0, 0), cA, voffA); PG8_STAGE(PG8_SB(0, 1), cB + hstep, voffB); PG8_STAGE(PG8_SA(0, 1), cA + hstep, voffA);
        if (wr == 1) PG8_BAR;
        PG8_WAIT_V(4); PG8_BAR;
        PG8_STAGE(PG8_SB(1, 0), cB + kstep, voffB); PG8_STAGE(PG8_SA(1, 0), cA + kstep, voffA); PG8_STAGE(PG8_SB(1, 1), cB + hstep + kstep, voffB);
        PG8_WAIT_V(6); PG8_BAR;
    }
    for (;;) {
        const bool has_next = S.next(ui + 1, nxt);
        const char* nA = has_next ? (const char*)g.A + (size_t)nxt.pm * tstep : cA; const char* nB = has_next ? (const char*)g.Bt + (size_t)nxt.pn * tstep : cB;
        for (int t = 0; t < nt; t += 2) {
            const bool last = (t == nt - 2);
            const char* a1 = cA + (size_t)(t + 1) * kstep;
            const char* a2 = last ? nA : cA + (size_t)(t + 2) * kstep; const char* b2 = last ? nB : cB + (size_t)(t + 2) * kstep;
            const char* a3 = a2 + kstep; const char* b3 = b2 + kstep;
            if (last && has_next) S.a_ready(nxt);
            if constexpr (SP2) {
            PG8_LDB(B0, 0, 0); PG8_LDB(B1, 0, 1); PG8_SCHED; PG8_LDA(At, 0, 0); PG8_STAGE(PG8_SA(1, 1), a1 + hstep, voffA);
            PG8_WAIT_V(8); PG8_WAIT_L(0); PG8_BAR; PG8_MMA(0, 0, At, B0); PG8_MMA(0, 1, At, B1); PG8_BAR; PG8_SCHED;
            PG8_LDA(At, 0, 1); PG8_STAGE(PG8_SB(0, 0), b2, voffB); PG8_STAGE(PG8_SB(0, 1), b2 + hstep, voffB); PG8_STAGE(PG8_SA(0, 0), a2, voffA);
            PG8_WAIT_V(8); PG8_WAIT_L(0); PG8_BAR; PG8_MMA(1, 0, At, B0); PG8_MMA(1, 1, At, B1); PG8_BAR; PG8_SCHED;
            PG8_LDB(B0, 1, 0); PG8_LDB(B1, 1, 1); PG8_SCHED; PG8_LDA(At, 1, 0); PG8_STAGE(PG8_SA(0, 1), a2 + hstep, voffA);
            PG8_WAIT_V(8); PG8_WAIT_L(0); PG8_BAR; PG8_MMA(0, 0, At, B0); PG8_MMA(0, 1, At, B1); PG8_BAR; PG8_SCHED;
            PG8_LDA(At, 1, 1); PG8_STAGE(PG8_SB(1, 0), b3, voffB); PG8_STAGE(PG8_SB(1, 1), b3 + hstep, voffB); PG8_STAGE(PG8_SA(1, 0), a3, voffA);
            PG8_WAIT_V(8); PG8_WAIT_L(0); PG8_BAR; PG8_MMA(1, 0, At, B0); PG8_MMA(1, 1, At, B1); PG8_BAR; PG8_SCHED;
            } else {
            PG8_LDB(B0, 0, 0); PG8_SCHED; PG8_LDA(At, 0, 0); PG8_STAGE(PG8_SA(1, 1), a1 + hstep, voffA);
            PG8_WAIT_L(8); PG8_BAR; PG8_WAIT_L(0); PG8_MMA(0, 0, At, B0); PG8_BAR; PG8_SCHED;
            PG8_LDB(B1, 0, 1); PG8_STAGE(PG8_SB(0, 0), b2, voffB);
            PG8_BAR; PG8_WAIT_L(0); PG8_MMA(0, 1, At, B1); PG8_BAR;
            PG8_LDA(At, 0, 1); PG8_STAGE(PG8_SA(0, 0), a2, voffA);
            PG8_BAR; PG8_WAIT_L(0); PG8_MMA(1, 0, At, B0); PG8_BAR; PG8_SCHED;
            PG8_STAGE(PG8_SB(0, 1), b2 + hstep, voffB);
            PG8_WAIT_V(6); PG8_BAR; PG8_MMA(1, 1, At, B1); PG8_BAR;
            PG8_LDB(B0, 1, 0); PG8_SCHED; PG8_LDA(At, 1, 0); PG8_STAGE(PG8_SA(0, 1), a2 + hstep, voffA);
            PG8_WAIT_L(8); PG8_BAR; PG8_WAIT_L(0); PG8_MMA(0, 0, At, B0); PG8_BAR; PG8_SCHED;
            PG8_LDB(B1, 1, 1); PG8_STAGE(PG8_SB(1, 0), b3, voffB);
            PG8_BAR; PG8_WAIT_L(0); PG8_MMA(0, 1, At, B1); PG8_BAR;
            PG8_LDA(At, 1, 1); PG8_STAGE(PG8_SA(1, 0), a3, voffA);
            PG8_BAR; PG8_WAIT_L(0); PG8_MMA(1, 0, At, B0); PG8_BAR; PG8_SCHED;
            PG8_STAGE(PG8_SB(1, 1), b3 + hstep, voffB);
            PG8_WAIT_V(6); PG8_BAR; PG8_MMA(1, 1, At, B1); PG8_BAR;
            }
        }
        if constexpr (ALIGN_EPI) { if (wr == 0) PG8_BAR; }
        if constexpr (!Epi::AFTER_DRAIN) { E(acc, cur, wr, wc, fr, fq); S.done(cur); }
        if (!has_next) break;
#pragma unroll
        for (int a = 0; a < 2; ++a)
#pragma unroll
            for (int b = 0; b < 2; ++b)
#pragma unroll
                for (int m = 0; m < 4; ++m)
#pragma unroll
                    for (int n = 0; n < 2; ++n) acc[a][b][m][n] = (f32x4){0.f, 0.f, 0.f, 0.f};
        cur = nxt; cA = nA; cB = nB; ++ui;
        if constexpr (ALIGN_EPI) { if (wr == 1) PG8_BAR; }
    }
    PG8_WAIT_V(0);
    if constexpr (!ALIGN_EPI) { if (wr == 0) PG8_BAR; }
    PG8_BAR;
    if constexpr (Epi::AFTER_DRAIN) { E.fused(acc, cur, wr, wc, fr, fq, lds, wid, lane); S.done(cur); }
#undef PG8_SA
#undef PG8_SB
#undef PG8_STAGE
#undef PG8_LDA
#undef PG8_LDB
#undef PG8_MMA
#undef PG8_WAIT_V
#undef PG8_WAIT_L
#undef PG8_BAR
#undef PG8_SCHED
}
}
namespace pg8 {
__device__ __forceinline__ float bf_lo(unsigned w) { return __uint_as_float(w << 16); }
__device__ __forceinline__ float bf_hi(unsigned w) { return __uint_as_float(w & 0xffff0000u); }
__device__ __forceinline__ u32x4 pack8(f32x4 v0, f32x4 v1) { u32x4 w; w.x = cvt_pk_bf16(v0[0], v0[1]); w.y = cvt_pk_bf16(v0[2], v0[3]); w.z = cvt_pk_bf16(v1[0], v1[1]); w.w = cvt_pk_bf16(v1[2], v1[3]); return w; }
template <int MODE> struct EpiBf {
    static constexpr bool PERM = true, AFTER_DRAIN = false;
    bf16_t* O; size_t ldc; const float* bias; float qscale;
    __device__ __forceinline__ void operator()(const f32x4 (&acc)[2][2][4][2], const Unit& u, int wr, int wc, int fr, int fq) const {
        const int row0 = u.pm * BM + wr * 64 + fr; const int col0 = u.pn * BM + wc * 32 + 8 * fq;
        float sc = 1.f; if (MODE == 1) { if (((u.pn >> 1) & 1) == 0) sc = qscale; }
        float rs[2][4];
#pragma unroll
        for (int ai = 0; ai < 2; ++ai)
#pragma unroll
            for (int m = 0; m < 4; ++m) rs[ai][m] = (MODE == 4) ? bias[row0 + ai * HALF + m * 16] : 1.f;
        f32x4 bv[2][2];
#pragma unroll
        for (int bj = 0; bj < 2; ++bj)
#pragma unroll
            for (int n = 0; n < 2; ++n) bv[bj][n] = (MODE == 2) ? *(const f32x4*)(bias + col0 + bj * HALF + 4 * n) : (f32x4){0.f, 0.f, 0.f, 0.f};
#pragma unroll
        for (int ai = 0; ai < 2; ++ai)
#pragma unroll
            for (int m = 0; m < 4; ++m) { bf16_t* rowp = O + (size_t)(row0 + ai * HALF + m * 16) * ldc + col0;
#pragma unroll
                for (int bj = 0; bj < 2; ++bj) { f32x4 v0 = acc[ai][bj][m][0], v1 = acc[ai][bj][m][1];
                    if (MODE == 1) { v0 = v0 * sc; v1 = v1 * sc; }
                    if (MODE == 2) { v0 = v0 + bv[bj][0]; v1 = v1 + bv[bj][1];
#pragma unroll
                        for (int e = 0; e < 4; ++e) { v0[e] = __builtin_amdgcn_rcpf(1.0f + __builtin_amdgcn_exp2f(-1.4426950408889634f * v0[e])); v1[e] = __builtin_amdgcn_rcpf(1.0f + __builtin_amdgcn_exp2f(-1.4426950408889634f * v1[e])); } }
                    if (MODE == 3) {
#pragma unroll
                        for (int e = 0; e < 4; ++e) { const float a0 = fmaxf(v0[e], 0.f), a1 = fmaxf(v1[e], 0.f); v0[e] = a0 * a0; v1[e] = a1 * a1; } }
                    if (MODE == 4) { const float r_ = rs[ai][m];
#pragma unroll
                        for (int e = 0; e < 4; ++e) { const float a0 = fmaxf(v0[e], 0.f), a1 = fmaxf(v1[e], 0.f); v0[e] = a0 * a0 * r_; v1[e] = a1 * a1 * r_; } }
                    *(u32x4*)(rowp + bj * HALF) = pack8(v0, v1); } }
    }
};
template <bool FIRST> struct EpiBranch {
    static constexpr bool PERM = true, AFTER_DRAIN = false;
    bf16_t* Mg; const bf16_t* G; int gcol0; const float* gbias;
    __device__ __forceinline__ void operator()(const f32x4 (&acc)[2][2][4][2], const Unit& u, int wr, int wc, int fr, int fq) const {
        const int row0 = u.pm * BM + wr * 64 + fr; const int col0 = u.pn * BM + wc * 32 + 8 * fq;
        f32x4 bb[2][2];
#pragma unroll
        for (int bj = 0; bj < 2; ++bj)
#pragma unroll
            for (int n = 0; n < 2; ++n) bb[bj][n] = *(const f32x4*)(gbias + gcol0 + col0 + bj * HALF + 4 * n);
#pragma unroll
        for (int ai = 0; ai < 2; ++ai) {
#pragma unroll
          for (int mp = 0; mp < 2; ++mp) {
            u32x4 gq[2][2], mo[2][2];
#pragma unroll
            for (int mi = 0; mi < 2; ++mi)
#pragma unroll
                for (int bj = 0; bj < 2; ++bj) { const size_t row = (size_t)(row0 + ai * HALF + (2 * mp + mi) * 16); const int col = col0 + bj * HALF;
                    gq[mi][bj] = *(const u32x4*)(G + row * 3072 + gcol0 + col);
                    if (!FIRST) mo[mi][bj] = *(const u32x4*)(Mg + row * 1024 + col); }
#pragma unroll
            for (int mi = 0; mi < 2; ++mi)
#pragma unroll
                for (int bj = 0; bj < 2; ++bj) { const int m = 2 * mp + mi; const size_t row = (size_t)(row0 + ai * HALF + m * 16); const int col = col0 + bj * HALF;
                    const u32x4 g = gq[mi][bj];
                    f32x4 g0 = (f32x4){bf_lo(g.x), bf_hi(g.x), bf_lo(g.y), bf_hi(g.y)} + bb[bj][0], g1 = (f32x4){bf_lo(g.z), bf_hi(g.z), bf_lo(g.w), bf_hi(g.w)} + bb[bj][1];
                    f32x4 v0 = acc[ai][bj][m][0], v1 = acc[ai][bj][m][1];
#pragma unroll
                    for (int e = 0; e < 4; ++e) { v0[e] *= __builtin_amdgcn_rcpf(1.0f + __builtin_amdgcn_exp2f(-1.4426950408889634f * g0[e])); v1[e] *= __builtin_amdgcn_rcpf(1.0f + __builtin_amdgcn_exp2f(-1.4426950408889634f * g1[e])); }
                    if (!FIRST) { const u32x4 o = mo[mi][bj];
                        v0[0] += bf_lo(o.x); v0[1] += bf_hi(o.x); v0[2] += bf_lo(o.y); v0[3] += bf_hi(o.y);
                        v1[0] += bf_lo(o.z); v1[1] += bf_hi(o.z); v1[2] += bf_lo(o.w); v1[3] += bf_hi(o.w); }
                    *(u32x4*)(Mg + row * 1024 + col) = pack8(v0, v1); }
          }
        }
    }
};
struct BranchOrder {
    StaticOrder S0;
    __host__ __device__ void init(int M, int N, int G_, int c_) { S0.init(M, N, G_, c_); }
    __host__ __device__ bool next(int i, Unit& u) const { Unit t; if (!S0.next(i / 3, t)) return false; const int br = i % 3; u.pm = t.pm + br * (S0.nM); u.pn = t.pn + br * (S0.nN); return true; }
    __device__ __forceinline__ void a_ready(const Unit&) const {}
    __device__ __forceinline__ void done(const Unit&) const {}
};
struct EpiBranchAll {
    static constexpr bool PERM = true, AFTER_DRAIN = false;
    bf16_t* Mg; const bf16_t* G; const float* gbias; int nM, nN;
    __device__ __forceinline__ void operator()(const f32x4 (&acc)[2][2][4][2], const Unit& u, int wr, int wc, int fr, int fq) const {
        const int br = u.pm / nM, pm = u.pm - br * nM, pn = u.pn - br * nN, gcol0 = 1024 * br; const bool first = (br == 0);
        const int row0 = pm * BM + wr * 64 + fr; const int col0 = pn * BM + wc * 32 + 8 * fq;
        f32x4 bb[2][2];
#pragma unroll
        for (int bj = 0; bj < 2; ++bj)
#pragma unroll
            for (int n = 0; n < 2; ++n) bb[bj][n] = *(const f32x4*)(gbias + gcol0 + col0 + bj * HALF + 4 * n);
#pragma unroll
        for (int ai = 0; ai < 2; ++ai) {
#pragma unroll
          for (int mp = 0; mp < 2; ++mp) {
            u32x4 gq[2][2], mo[2][2];
#pragma unroll
            for (int mi = 0; mi < 2; ++mi)
#pragma unroll
                for (int bj = 0; bj < 2; ++bj) { const size_t row = (size_t)(row0 + ai * HALF + (2 * mp + mi) * 16); const int col = col0 + bj * HALF;
                    gq[mi][bj] = *(const u32x4*)(G + row * 3072 + gcol0 + col);
                    mo[mi][bj] = first ? (u32x4){0u, 0u, 0u, 0u} : *(const u32x4*)(Mg + row * 1024 + col); }
#pragma unroll
            for (int mi = 0; mi < 2; ++mi)
#pragma unroll
                for (int bj = 0; bj < 2; ++bj) { const int m = 2 * mp + mi; const size_t row = (size_t)(row0 + ai * HALF + m * 16); const int col = col0 + bj * HALF;
                    const u32x4 g = gq[mi][bj];
                    f32x4 g0 = (f32x4){bf_lo(g.x), bf_hi(g.x), bf_lo(g.y), bf_hi(g.y)} + bb[bj][0], g1 = (f32x4){bf_lo(g.z), bf_hi(g.z), bf_lo(g.w), bf_hi(g.w)} + bb[bj][1];
                    f32x4 v0 = acc[ai][bj][m][0], v1 = acc[ai][bj][m][1];
#pragma unroll
                    for (int e = 0; e < 4; ++e) { v0[e] *= __builtin_amdgcn_rcpf(1.0f + __builtin_amdgcn_exp2f(-1.4426950408889634f * g0[e])); v1[e] *= __builtin_amdgcn_rcpf(1.0f + __builtin_amdgcn_exp2f(-1.4426950408889634f * g1[e])); }
                    const u32x4 o = mo[mi][bj];
                    v0[0] += bf_lo(o.x); v0[1] += bf_hi(o.x); v0[2] += bf_lo(o.y); v0[3] += bf_hi(o.y);
                    v1[0] += bf_lo(o.z); v1[1] += bf_hi(o.z); v1[2] += bf_lo(o.w); v1[3] += bf_hi(o.w);
                    *(u32x4*)(Mg + row * 1024 + col) = pack8(v0, v1); }
          }
        }
    }
};
struct EpiResid {
    static constexpr bool PERM = false, AFTER_DRAIN = false;
    const float* base; float* out;
    __device__ __forceinline__ void operator()(const f32x4 (&acc)[2][2][4][2], const Unit& u, int wr, int wc, int fr, int fq) const {
        const int row0 = u.pm * BM + wr * 64 + fr; const int col0 = u.pn * BM + wc * 32 + 4 * fq;
#pragma unroll
        for (int ai = 0; ai < 2; ++ai) {
#pragma unroll
          for (int mp = 0; mp < 2; ++mp) {
            f32x4 bs[2][2][2];
#pragma unroll
            for (int mi = 0; mi < 2; ++mi) { const size_t off = (size_t)(row0 + ai * HALF + (2 * mp + mi) * 16) * 1024 + col0;
#pragma unroll
                for (int bj = 0; bj < 2; ++bj)
#pragma unroll
                    for (int n = 0; n < 2; ++n) bs[mi][bj][n] = *(const f32x4*)(base + off + bj * HALF + n * 16); }
#pragma unroll
            for (int mi = 0; mi < 2; ++mi) { const int m = 2 * mp + mi; const size_t off = (size_t)(row0 + ai * HALF + m * 16) * 1024 + col0;
#pragma unroll
                for (int bj = 0; bj < 2; ++bj)
#pragma unroll
                    for (int n = 0; n < 2; ++n) *(f32x4*)(out + off + bj * HALF + n * 16) = bs[mi][bj][n] + acc[ai][bj][m][n]; }
          }
        }
    }
};
struct EpiResidN {
    static constexpr bool PERM = false, AFTER_DRAIN = false;
    const float* base; float* out; bf16_t* xb; float* ssqp;
    __device__ __forceinline__ void operator()(const f32x4 (&acc)[2][2][4][2], const Unit& u, int wr, int wc, int fr, int fq) const {
        const int row0 = u.pm * BM + wr * 64 + fr; const int col0 = u.pn * BM + wc * 32 + 4 * fq;
#pragma unroll
        for (int ai = 0; ai < 2; ++ai) {
#pragma unroll
          for (int mp = 0; mp < 2; ++mp) {
            f32x4 bs[2][2][2];
#pragma unroll
            for (int mi = 0; mi < 2; ++mi) { const size_t off = (size_t)(row0 + ai * HALF + (2 * mp + mi) * 16) * 1024 + col0;
#pragma unroll
                for (int bj = 0; bj < 2; ++bj)
#pragma unroll
                    for (int n = 0; n < 2; ++n) bs[mi][bj][n] = *(const f32x4*)(base + off + bj * HALF + n * 16); }
#pragma unroll
            for (int mi = 0; mi < 2; ++mi) { const int m = 2 * mp + mi; const int row = row0 + ai * HALF + m * 16; const size_t off = (size_t)row * 1024 + col0;
                float sq = 0.f;
#pragma unroll
                for (int bj = 0; bj < 2; ++bj)
#pragma unroll
                    for (int n = 0; n < 2; ++n) { const f32x4 v = bs[mi][bj][n] + acc[ai][bj][m][n];
                        *(f32x4*)(out + off + bj * HALF + n * 16) = v;
                        u32x2v w; w.x = cvt_pk_bf16(v[0], v[1]); w.y = cvt_pk_bf16(v[2], v[3]); *(u32x2v*)(xb + off + bj * HALF + n * 16) = w;
                        sq += (v[0] * v[0] + v[1] * v[1]) + (v[2] * v[2] + v[3] * v[3]); }
                sq += __uint_as_float((unsigned)__builtin_amdgcn_ds_swizzle((int)__float_as_uint(sq), 0x401F));
                { auto rr = __builtin_amdgcn_permlane32_swap(__float_as_uint(sq), __float_as_uint(sq), false, false); sq = __uint_as_float(rr[0]) + __uint_as_float(rr[1]); }
                if (fq == 0) ssqp[(size_t)row * 16 + u.pn * 4 + wc] = sq; }
          }
        }
    }
};
}
#define LAS __attribute__((address_space(3)))
typedef unsigned short bf16_t;
typedef short bf16x8 __attribute__((ext_vector_type(8)));
typedef short s16x4 __attribute__((ext_vector_type(4)));
typedef float f32x4 __attribute__((ext_vector_type(4)));
typedef float f32x16 __attribute__((ext_vector_type(16)));
typedef unsigned u32x4 __attribute__((ext_vector_type(4)));
typedef unsigned u32x2 __attribute__((ext_vector_type(2)));
constexpr int NB = 8, S = 8192, D = 1024, T = NB * S, FF = 4096, INW = 4616, DEPTH = 2;
constexpr int QKW = 3072, VW = 1536, YW = 1536, GW = 3072;
constexpr float EPS = 1e-6f, LOG2E = 1.4426950408889634f, C2 = 0.125f * 1.4426950408889634f;
constexpr size_t MiB = 1u << 20;
constexpr size_t WS_CTL = 0, WS_W = 2 * MiB, W_LAYER = 36 * MiB;
constexpr size_t WO_QK = 0, WO_V = 6 * MiB, WO_G = 9 * MiB, WO_BR = 15 * MiB, WO_O = 18 * MiB, WO_1 = 20 * MiB, WO_2 = 28 * MiB;
constexpr size_t WS_F = 74 * MiB, WS_H = 76 * MiB, WS_QK = 204 * MiB, WS_VT = 588 * MiB, WS_Y = 780 * MiB, WS_PARK = 972 * MiB, WS_ROPE = 1004 * MiB  , WS_END = 1010 * MiB;
constexpr size_t WS_G = WS_QK, WS_MG = WS_VT, WS_FFH = WS_QK;
static_assert(WS_H + (size_t)T * D * 2 == WS_QK && WS_QK + (size_t)T * QKW * 2 == WS_VT && WS_VT + (size_t)VW * T * 2 == WS_Y && WS_Y + (size_t)T * YW * 2 == WS_PARK, "ws map");
static_assert((size_t)T * FF * 2 <= WS_Y - WS_QK, "ffh overlay");
constexpr int CW_BAR = 4096;
constexpr size_t CTL_ZERO_BYTES = 65536;
constexpr int LDS_BYTES = 147456, RING_BYTES = 131072, MISC_OFF = RING_BYTES;

struct Args { const void* in[18]; float* out; unsigned char* ws; };

#define DPP_ADD(v, ctrl) ((v) + __uint_as_float((unsigned)__builtin_amdgcn_update_dpp(0, (int)__float_as_uint(v), (ctrl), 0xF, 0xF, true)))
__device__ __forceinline__ float xor32_sum(float v) { auto rr = __builtin_amdgcn_permlane32_swap(__float_as_uint(v), __float_as_uint(v), false, false); return __uint_as_float(rr[0]) + __uint_as_float(rr[1]); }
__device__ __forceinline__ float xor32_max(float v) { auto rr = __builtin_amdgcn_permlane32_swap(__float_as_uint(v), __float_as_uint(v), false, false); return fmaxf(__uint_as_float(rr[0]), __uint_as_float(rr[1])); }
__device__ __forceinline__ float wave_sum(float v) {
    v = DPP_ADD(v, 0xB1); v = DPP_ADD(v, 0x4E); v = DPP_ADD(v, 0x141); v = DPP_ADD(v, 0x140);
    v += __uint_as_float((unsigned)__builtin_amdgcn_ds_swizzle((int)__float_as_uint(v), 0x401F));
    return xor32_sum(v);
}
__device__ __forceinline__ unsigned pk_bf16(float lo, float hi) { return pg8::cvt_pk_bf16(lo, hi); }

__device__ __forceinline__ void transpose_item(const float* W, int ldw, int K, int ncols, bf16_t* WT, LAS float* scr, int item, int lane, const float* kgain = nullptr) {
    const int nblk = ncols / 32, kb = item / nblk, nb = item % nblk, k0 = 64 * kb, n0 = 32 * nb;
    { f32x4 wv[8];
#pragma unroll
      for (int i = 0; i < 8; ++i) wv[i] = *(const f32x4*)(W + (size_t)(k0 + 8 * i + (lane >> 3)) * ldw + n0 + 4 * (lane & 7));
#pragma unroll
      for (int i = 0; i < 8; ++i) { const float kg = kgain ? kgain[k0 + 8 * i + (lane >> 3)] : 1.0f; LAS float* d = scr + (8 * i + (lane >> 3)) * 33 + 4 * (lane & 7);
          d[0] = wv[i].x * kg; d[1] = wv[i].y * kg; d[2] = wv[i].z * kg; d[3] = wv[i].w * kg; } }
    asm volatile("s_waitcnt lgkmcnt(0)" ::: "memory");
    const int c = lane & 7;
#pragma unroll
    for (int j = 0; j < 4; ++j) { const int n = (lane >> 3) + 8 * j; const LAS float* s = scr + (8 * c) * 33 + n;
        u32x4 o; o.x = pk_bf16(s[0 * 33], s[1 * 33]); o.y = pk_bf16(s[2 * 33], s[3 * 33]); o.z = pk_bf16(s[4 * 33], s[5 * 33]); o.w = pk_bf16(s[6 * 33], s[7 * 33]);
        *(u32x4*)(WT + (size_t)(n0 + n) * K + k0 + 8 * c) = o; }
    asm volatile("s_waitcnt lgkmcnt(0)" ::: "memory");
}
__device__ __forceinline__ void convert_weights(const Args& a, LAS unsigned char* lds, int gw, int NGW, int wave, int lane) {
    LAS float* scr = (LAS float*)(lds + wave * 16384);
    constexpr int I_IN = 9 * 256, I_G = 16 * 96, I_BR = 8 * 32, I_O = 16 * 32, I_1 = 16 * 128, I_2 = 64 * 32;
    constexpr int PER_LAYER = I_IN + I_G + 3 * I_BR + I_O + I_1 + I_2;
    for (int it = gw; it < DEPTH * PER_LAYER; it += NGW) {
        const int l = it / PER_LAYER; int r = it % PER_LAYER;
        unsigned char* wl = a.ws + WS_W + (size_t)l * W_LAYER;
        if (r < I_IN) { const int seg = r / 256, ri = r % 256, typ = seg % 3, grp = seg / 3;
            const float* W = (const float*)a.in[3] + (size_t)l * D * INW + seg * 512;
            bf16_t* dst = (typ == 2) ? (bf16_t*)(wl + WO_V) + (size_t)(512 * grp) * D : (bf16_t*)(wl + WO_QK) + (size_t)(1024 * grp + 512 * typ) * D;
            transpose_item(W, INW, D, 512, dst, scr, ri, lane); continue; }
        r -= I_IN;
        if (r < I_G) { transpose_item((const float*)a.in[11] + (size_t)l * D * 3072, 3072, D, 3072, (bf16_t*)(wl + WO_G), scr, r, lane); continue; }
        r -= I_G;
        if (r < 3 * I_BR) { const int br = r / I_BR, ri = r % I_BR; const float* W = (const float*)a.in[8 + br] + (size_t)l * 512 * D;
            transpose_item(W, D, 512, D, (bf16_t*)(wl + WO_BR) + (size_t)br * D * 512, scr, ri, lane); continue; }
        r -= 3 * I_BR;
        if (r < I_O) { transpose_item((const float*)a.in[13] + (size_t)l * D * D, D, D, D, (bf16_t*)(wl + WO_O), scr, r, lane); continue; }
        r -= I_O;
        if (r < I_1) { transpose_item((const float*)a.in[15] + (size_t)l * D * FF, FF, D, FF, (bf16_t*)(wl + WO_1), scr, r, lane, (const float*)a.in[14] + (size_t)l * D); continue; }
        r -= I_1;
        transpose_item((const float*)a.in[16] + (size_t)l * FF * D, D, FF, D, (bf16_t*)(wl + WO_2), scr, r, lane);
    }
}

__device__ __forceinline__ float log_sigmoid(float x) { return fminf(x, 0.f) - log1pf(expf(-fabsf(x))); }
template <int MODE>
__device__ __forceinline__ void rmsnorm_phase(const float* X, const float* gain, bf16_t* H, float* OutF, const float* w_in_l, const float* b_forget_l, float* F,
                                              LAS unsigned char* lds, int gw, int NGW, int tid, int lane) {
    LAS float* wfl = (LAS float*)lds;
    if (MODE == 1) {
#pragma unroll
        for (int e = 0; e < 16; ++e) { const int idx = tid + 512 * e, k = idx >> 3, j = idx & 7; wfl[j * 1024 + k] = w_in_l[(size_t)k * INW + 4608 + j]; }
        __syncthreads();
    }
    f32x4 g[4];
#pragma unroll
    for (int j = 0; j < 4; ++j) g[j] = *((const f32x4*)gain + lane + 64 * j);
    for (int m = gw; m < T; m += NGW) {
        const f32x4* xr = (const f32x4*)(X + (size_t)m * D) + lane;
        f32x4 v[4]; float s = 0.f;
#pragma unroll
        for (int j = 0; j < 4; ++j) { v[j] = xr[64 * j]; s += (v[j].x * v[j].x + v[j].y * v[j].y) + (v[j].z * v[j].z + v[j].w * v[j].w); }
        const float rstd = 1.0f / sqrtf(wave_sum(s) * (1.f / D) + EPS);
#pragma unroll
        for (int j = 0; j < 4; ++j) v[j] = v[j] * rstd * g[j];
        if (MODE == 2) {
            f32x4* o = (f32x4*)(OutF + (size_t)m * D) + lane;
#pragma unroll
            for (int j = 0; j < 4; ++j) o[64 * j] = v[j];
        } else {
            u32x2* o = (u32x2*)(H + (size_t)m * D) + lane;
#pragma unroll
            for (int j = 0; j < 4; ++j) { u32x2 w; w.x = pk_bf16(v[j].x, v[j].y); w.y = pk_bf16(v[j].z, v[j].w); o[64 * j] = w; }
        }
        if (MODE == 1) {
            float fa[8];
#pragma unroll
            for (int h = 0; h < 8; ++h) { float acc = 0.f;
#pragma unroll
                for (int j = 0; j < 4; ++j) { const f32x4 w = *(const LAS f32x4*)(wfl + h * 1024 + 4 * lane + 256 * j); acc += (v[j].x * w.x + v[j].y * w.y) + (v[j].z * w.z + v[j].w * w.w); }
                fa[h] = wave_sum(acc); }
            float mine = fa[0];
#pragma unroll
            for (int h = 1; h < 8; ++h) mine = (lane == h) ? fa[h] : mine;
            if (lane < 8) { const int b = m / S, s_ = m % S; F[((size_t)b * 8 + lane) * S + s_] = log_sigmoid(mine + b_forget_l[lane]); }
        }
    }
    if (MODE == 1) __syncthreads();
}
__device__ __forceinline__ void fcumsum(float* F, LAS unsigned char* lds, int tid, int lane, int wave) {
    LAS double* wt = (LAS double*)lds;
    for (int seq = blockIdx.x; seq < NB * 8; seq += gridDim.x) {
        f32x4* p = (f32x4*)(F + (size_t)seq * S + tid * 16);
        f32x4 v[4]; double c[16]; double run = 0.0;
#pragma unroll
        for (int j = 0; j < 4; ++j) { v[j] = p[j];
#pragma unroll
            for (int e = 0; e < 4; ++e) { run += (double)v[j][e]; c[4 * j + e] = run; } }
        double inc = run;
#pragma unroll
        for (int o = 1; o < 64; o <<= 1) { const double t = __shfl_up(inc, o); if (lane >= o) inc += t; }
        if (lane == 63) wt[wave] = inc;
        __syncthreads();
        double base = inc - run;
#pragma unroll
        for (int w = 0; w < 8; ++w) if (w < wave) base += wt[w];
#pragma unroll
        for (int j = 0; j < 4; ++j) { f32x4 o;
#pragma unroll
            for (int e = 0; e < 4; ++e) o[e] = (float)(base + c[4 * j + e]);
            p[j] = o; }
        __syncthreads();
    }
}
__device__ __forceinline__ void rope_table_phase(float* tab, const int* positions, int gw, int NGW, int lane) {
    const int i = lane & 7;
    const float invf = (i == 0) ? 1.0f : (i == 1) ? 0.19392274474868576f : (i == 2) ? 0.03760603093086393f : (i == 3) ? 0.007292664737217109f
                     : (i == 4) ? 0.001414213562373095f : (i == 5) ? 0.0002742481756762073f : (i == 6) ? 5.318295896944988e-05f : 1.031338537721246e-05f;
    for (int r8 = gw; r8 < T / 8; r8 += NGW) { const int row = r8 * 8 + (lane >> 3);
        float sn, cs; sincosf((float)positions[row] * invf, &sn, &cs);
        tab[(size_t)row * 16 + i] = cs; tab[(size_t)row * 16 + 8 + i] = sn; }
}
__device__ __forceinline__ void rope_phase(bf16_t* QK, const float* tab, int gw, int NGW, int lane) {
    for (int r4 = gw; r4 < T / 4; r4 += NGW) {
        const int row = r4 * 4 + (lane >> 4), j = lane & 15;
        const f32x4* tp = (const f32x4*)(tab + (size_t)row * 16);
        const f32x4 c0 = tp[0], c1 = tp[1], s0 = tp[2], s1 = tp[3];
        const float cs[8] = {c0.x, c0.y, c0.z, c0.w, c1.x, c1.y, c1.z, c1.w}, sn[8] = {s0.x, s0.y, s0.z, s0.w, s1.x, s1.y, s1.z, s1.w};
        bf16_t* p = QK + (size_t)row * QKW + 1024 + 64 * j;
        const u32x4 a = *(const u32x4*)p, b = *(const u32x4*)(p + 8);
        float x1[8], x2[8];
        x1[0] = pg8::bf_lo(a.x); x1[1] = pg8::bf_hi(a.x); x1[2] = pg8::bf_lo(a.y); x1[3] = pg8::bf_hi(a.y); x1[4] = pg8::bf_lo(a.z); x1[5] = pg8::bf_hi(a.z); x1[6] = pg8::bf_lo(a.w); x1[7] = pg8::bf_hi(a.w);
        x2[0] = pg8::bf_lo(b.x); x2[1] = pg8::bf_hi(b.x); x2[2] = pg8::bf_lo(b.y); x2[3] = pg8::bf_hi(b.y); x2[4] = pg8::bf_lo(b.z); x2[5] = pg8::bf_hi(b.z); x2[6] = pg8::bf_lo(b.w); x2[7] = pg8::bf_hi(b.w);
        float y1[8], y2[8];
#pragma unroll
        for (int i = 0; i < 8; ++i) { y1[i] = x1[i] * cs[i] - x2[i] * sn[i]; y2[i] = x2[i] * cs[i] + x1[i] * sn[i]; }
        u32x4 oa, ob;
        oa.x = pk_bf16(y1[0], y1[1]); oa.y = pk_bf16(y1[2], y1[3]); oa.z = pk_bf16(y1[4], y1[5]); oa.w = pk_bf16(y1[6], y1[7]);
        ob.x = pk_bf16(y2[0], y2[1]); ob.y = pk_bf16(y2[2], y2[3]); ob.z = pk_bf16(y2[4], y2[5]); ob.w = pk_bf16(y2[6], y2[7]);
        *(u32x4*)p = oa; *(u32x4*)(p + 8) = ob;
    }
}
__device__ __forceinline__ unsigned xb_xcc_id_early() { return (unsigned)__builtin_amdgcn_s_getreg((3 << 11) | 20) & 0xFu; }
namespace att {
constexpr int KSTR = 144, VSTR = 144;
constexpr int OFF_K = 0, OFF_V = 2 * 64 * KSTR  , OFF_FK = OFF_V + 2 * 128 * VSTR  , OFF_RB = OFF_FK + 512, OFF_END = OFF_RB + 1040;
static_assert(OFF_END <= RING_BYTES, "attention LDS");
__device__ __forceinline__ int crow(int r, int hi) { return (r & 3) + 8 * (r >> 2) + 4 * hi; }
__device__ __forceinline__ unsigned cvtpk(float lo, float hi) { return pg8::cvt_pk_bf16(lo, hi); }

template <int TYPE, int DV>
__device__ __forceinline__ void attn_pass(LAS unsigned char* lds, const bf16_t* QK, const bf16_t* VT, const float* Fbh, int tok0, int qcol, int kcol, int vrow,
                                          int q0, int t_lo, int t_hi, f32x16 (&o)[DV / 32]) {
    int tid_ = threadIdx.x; asm volatile("" : "+v"(tid_));
    const int tid = tid_, lane = tid & 63, r32 = lane & 31, hi = lane >> 5; const int wid = __builtin_amdgcn_readfirstlane(tid >> 6);
    const int q0w = q0 + 32 * wid, cw = q0w >> 6;
    bf16x8 qf[4];
    { const bf16_t* qp = QK + (size_t)(tok0 + q0w + r32) * QKW + qcol + 8 * hi;
#pragma unroll
      for (int d0 = 0; d0 < 4; ++d0) qf[d0] = *(const bf16x8*)(qp + 16 * d0); }
    float Fq = 0.f; if (TYPE == 2) Fq = Fbh[q0w + r32] * LOG2E;
#pragma unroll
    for (int db = 0; db < DV / 32; ++db)
#pragma unroll
        for (int r = 0; r < 16; ++r) o[db][r] = 0.f;
    float m_run = 0.f, l_run = 0.f;
    const int krow = tid >> 3, kch = tid & 7;
    const bf16_t* ksrc = QK + (size_t)(tok0 + krow) * QKW + kcol + 8 * kch;
    const bf16_t* vsrc = VT + (size_t)(vrow + krow) * T + tok0 + 8 * kch;
    const int kdst = OFF_K + krow * KSTR + kch * 16, vdst = OFF_V + krow * VSTR + (kch >> 1) * 32 + (kch & 1) * 8;
    u32x4 kreg, vreg0, vreg1; float freg = 0.f;
    vreg1 = (u32x4){0u, 0u, 0u, 0u};
#define ATT_LOAD(t) do { kreg = *(const u32x4*)(ksrc + (size_t)(t) * 64 * QKW); vreg0 = *(const u32x4*)(vsrc + (size_t)(t) * 64); \
        if (DV == 128) vreg1 = *(const u32x4*)(vsrc + (size_t)(t) * 64 + (size_t)64 * T); if (TYPE == 2) { if (tid < 64) freg = Fbh[(t) * 64 + tid] * LOG2E; } } while (0)
#define ATT_STORE(buf) do { *(LAS u32x4*)(lds + kdst + (buf) * 64 * KSTR) = kreg; \
        *(LAS u32x2*)(lds + vdst + (buf) * 128 * VSTR) = (u32x2){vreg0.x, vreg0.y}; *(LAS u32x2*)(lds + vdst + (buf) * 128 * VSTR + 16) = (u32x2){vreg0.z, vreg0.w}; \
        if (DV == 128) { *(LAS u32x2*)(lds + vdst + (buf) * 128 * VSTR + 64 * VSTR) = (u32x2){vreg1.x, vreg1.y}; *(LAS u32x2*)(lds + vdst + (buf) * 128 * VSTR + 64 * VSTR + 16) = (u32x2){vreg1.z, vreg1.w}; } \
        if (TYPE == 2) { if (tid < 64) *(LAS float*)(lds + OFF_FK + (buf) * 256 + tid * 4) = freg; } } while (0)
#define ATT_BAR() do { asm volatile("s_waitcnt lgkmcnt(0)" ::: "memory"); __builtin_amdgcn_s_barrier(); asm volatile("" ::: "memory"); } while (0)
    ATT_LOAD(t_lo); ATT_STORE(0);
    ATT_BAR();
    for (int t = t_lo; t <= t_hi; ++t) {
        const int buf = (t - t_lo) & 1;
        if (t < t_hi) ATT_LOAD(t + 1);
        bool part;
        if (TYPE == 0) part = (t >= cw - 8) && (t <= cw);
        else if (TYPE == 1) part = (t <= cw);
        else part = (64 * t <= q0w + 31);
        if (part) {
            const LAS unsigned char* Kb = lds + OFF_K + buf * 64 * KSTR;
            const LAS unsigned char* Vb = lds + OFF_V + buf * 128 * VSTR;
            bf16x8 kf[8];
#pragma unroll
            for (int kb = 0; kb < 2; ++kb)
#pragma unroll
                for (int d0 = 0; d0 < 4; ++d0) kf[kb * 4 + d0] = *(const LAS bf16x8*)(Kb + (32 * kb + r32) * KSTR + d0 * 32 + hi * 16);
            f32x16 p[2];
            if (TYPE == 0) {
                const LAS float* rb = (const LAS float*)(lds + OFF_RB);
                if (t <= cw - 3) { const float c0 = rb[0] - m_run;
#pragma unroll
                    for (int kb = 0; kb < 2; ++kb)
#pragma unroll
                        for (int r = 0; r < 16; ++r) p[kb][r] = c0;
                } else {
                    const int base = 64 * t - (q0w + r32) + 128;
#pragma unroll
                    for (int kb = 0; kb < 2; ++kb)
#pragma unroll
                        for (int r = 0; r < 16; ++r) { int idx = base + 32 * kb + crow(r, hi); idx = idx < 0 ? 0 : (idx > 256 ? 256 : idx); p[kb][r] = rb[idx] - m_run; }
                }
            } else if (TYPE == 2) {
                const LAS float* fk = (const LAS float*)(lds + OFF_FK + buf * 256);
                const float c0 = Fq - m_run;
#pragma unroll
                for (int kb = 0; kb < 2; ++kb)
#pragma unroll
                    for (int g = 0; g < 4; ++g) { const f32x4 f4 = *(const LAS f32x4*)(fk + 32 * kb + 8 * g + 4 * hi);
#pragma unroll
                        for (int e = 0; e < 4; ++e) p[kb][4 * g + e] = c0 - f4[e]; }
            } else {
                const float c0 = -m_run;
#pragma unroll
                for (int kb = 0; kb < 2; ++kb)
#pragma unroll
                    for (int r = 0; r < 16; ++r) p[kb][r] = c0;
            }
#pragma unroll
            for (int kb = 0; kb < 2; ++kb)
#pragma unroll
                for (int d0 = 0; d0 < 4; ++d0) p[kb] = __builtin_amdgcn_mfma_f32_32x32x16_bf16(kf[kb * 4 + d0], qf[d0], p[kb], 0, 0, 0);
            u32x4 vf[2][DV / 32];
#pragma unroll
            for (int j = 0; j < 2; ++j)
#pragma unroll
                for (int db = 0; db < DV / 32; ++db) vf[j][db] = *(const LAS u32x4*)(Vb + (32 * db + r32) * VSTR + 32 * j + 16 * hi);
            if (TYPE == 2) { if (64 * t + 63 > q0w) { const int qq = q0w + r32 - 64 * t;
#pragma unroll
                for (int kb = 0; kb < 2; ++kb)
#pragma unroll
                    for (int r = 0; r < 16; ++r) if (32 * kb + crow(r, hi) > qq) p[kb][r] = -INFINITY; } }
            float mx0 = fmaxf(fmaxf(p[0][0], p[0][1]), p[0][2]), mx1 = fmaxf(fmaxf(p[1][0], p[1][1]), p[1][2]);
#pragma unroll
            for (int r = 3; r < 15; r += 2) { mx0 = fmaxf(fmaxf(mx0, p[0][r]), p[0][r + 1]); mx1 = fmaxf(fmaxf(mx1, p[1][r]), p[1][r + 1]); }
            float mx = fmaxf(fmaxf(mx0, mx1), fmaxf(p[0][15], p[1][15]));
            mx = xor32_max(mx);
            if (__any(mx > 8.0f)) {
                const float dl = mx > 8.0f ? mx : 0.f, al = __builtin_amdgcn_exp2f(-dl);
                m_run += dl; l_run *= al;
#pragma unroll
                for (int db = 0; db < DV / 32; ++db)
#pragma unroll
                    for (int r = 0; r < 16; ++r) o[db][r] *= al;
#pragma unroll
                for (int kb = 0; kb < 2; ++kb)
#pragma unroll
                    for (int r = 0; r < 16; ++r) p[kb][r] -= dl;
            }
            float ls0 = 0.f, ls1 = 0.f;
#pragma unroll
            for (int r = 0; r < 16; ++r) { p[0][r] = __builtin_amdgcn_exp2f(p[0][r]); p[1][r] = __builtin_amdgcn_exp2f(p[1][r]); ls0 += p[0][r]; ls1 += p[1][r]; }
            l_run += ls0 + ls1;
            u32x4 vg[2][DV / 32];
#pragma unroll
            for (int j = 0; j < 2; ++j)
#pragma unroll
                for (int db = 0; db < DV / 32; ++db) vg[j][db] = *(const LAS u32x4*)(Vb + (32 * db + r32) * VSTR + 32 * (2 + j) + 16 * hi);
#pragma unroll
            for (int kb = 0; kb < 2; ++kb)
#pragma unroll
                for (int j = 0; j < 2; ++j) {
                    u32x4 pw; pw.x = cvtpk(p[kb][8 * j + 0], p[kb][8 * j + 1]); pw.y = cvtpk(p[kb][8 * j + 2], p[kb][8 * j + 3]); pw.z = cvtpk(p[kb][8 * j + 4], p[kb][8 * j + 5]); pw.w = cvtpk(p[kb][8 * j + 6], p[kb][8 * j + 7]);
                    const bf16x8 pf = __builtin_bit_cast(bf16x8, pw);
#pragma unroll
                    for (int db = 0; db < DV / 32; ++db) {
                        const u32x4 vw = (kb == 0) ? vf[j][db] : vg[j][db];
                        o[db] = __builtin_amdgcn_mfma_f32_32x32x16_bf16(__builtin_bit_cast(bf16x8, vw), pf, o[db], 0, 0, 0);
                    }
                }
        }
        if (t < t_hi) ATT_STORE(buf ^ 1);
        ATT_BAR();
    }
#undef ATT_BAR
#undef ATT_LOAD
#undef ATT_STORE
    l_run = xor32_sum(l_run);
    const float inv = 1.0f / l_run;
#pragma unroll
    for (int db = 0; db < DV / 32; ++db)
#pragma unroll
        for (int r = 0; r < 16; ++r) o[db][r] *= inv;
}
template <int NDB>
__device__ __forceinline__ void store_y(bf16_t* Y, const f32x16 (&o)[NDB], int tokrow, int ycol, int hi) {
    bf16_t* yp = Y + (size_t)tokrow * 512 + ycol + 4 * hi;
#pragma unroll
    for (int db = 0; db < NDB; ++db)
#pragma unroll
        for (int g = 0; g < 4; ++g) { u32x2 w; w.x = cvtpk(o[db][4 * g + 0], o[db][4 * g + 1]); w.y = cvtpk(o[db][4 * g + 2], o[db][4 * g + 3]); *(u32x2*)(yp + 32 * db + 8 * g) = w; }
}
__device__ __forceinline__ void attention_phase(const Args& a, LAS unsigned char* lds, int layer, unsigned* counter) {
    int tid_ = threadIdx.x; asm volatile("" : "+v"(tid_));
    const int tid = tid_, lane = tid & 63, r32 = lane & 31, hi = lane >> 5; const int wid = __builtin_amdgcn_readfirstlane(tid >> 6);
    const bf16_t* QK = (const bf16_t*)(a.ws + WS_QK); const bf16_t* VT = (const bf16_t*)(a.ws + WS_VT); bf16_t* Y = (bf16_t*)(a.ws + WS_Y);
    const float* F = (const float*)(a.ws + WS_F);
    float* park = (float*)(a.ws + WS_PARK) + (size_t)blockIdx.x * (64 * 512);
    volatile LAS int* s_unit = (volatile LAS int*)(lds + MISC_OFF);
    const float lam_init = 0.8f - 0.6f * expf(-0.3f * (float)layer);
    float lam;
    { const float* L = (const float*)a.in[5] + (size_t)layer * 256;
      const float s01 = wave_sum(L[lane] * L[64 + lane]), s23 = wave_sum(L[128 + lane] * L[192 + lane]);
      lam = expf(s01) - expf(s23) + lam_init; }
    const int myx = (int)(xb_xcc_id_early() & 7u);
    int qq = 0;
    for (;;) {
        const int xq = (myx + qq) & 7;
        if (tid == 0) *s_unit = (int)atomicAdd(counter + 16 * xq, 1u);
        __syncthreads();
        const int jq = *s_unit;
        __syncthreads();
        if (jq >= 640) { if (++qq == 8) break; continue; }
        int u;
        if (jq < 128) { const int qbi = jq >> 2, bh = xq + 8 * (jq & 3); u = qbi * 32 + bh; }
        else if (jq < 384) { const int i = jq - 128, qbi = i >> 3, bh = xq + 8 * (i & 7); u = 1024 + qbi * 64 + bh; }
        else { const int i = jq - 384, qbi = i >> 3, bh = xq + 8 * (i & 7); u = 3072 + qbi * 64 + bh; }
        if (u < 1024) {
            const int qb = 31 - (u >> 5), bh = u & 31, b = bh >> 2, h = bh & 3, tok0 = b * S, q0 = qb * 256;
            f32x16 o[4];
            attn_pass<1, 128>(lds, QK, VT, nullptr, tok0, 1024 + h * 128, 1536 + h * 128, 512 + h * 128, q0, 0, 4 * qb + 3, o);
            { f32x4* pk = (f32x4*)(park + (size_t)tid * 64);
#pragma unroll
              for (int db = 0; db < 4; ++db)
#pragma unroll
                for (int g = 0; g < 4; ++g) pk[db * 4 + g] = (f32x4){o[db][4 * g], o[db][4 * g + 1], o[db][4 * g + 2], o[db][4 * g + 3]}; }
            asm volatile("" ::: "memory");
            attn_pass<1, 128>(lds, QK, VT, nullptr, tok0, 1024 + h * 128 + 64, 1536 + h * 128 + 64, 512 + h * 128, q0, 0, 4 * qb + 3, o);
            float ssq = 0.f;
            { const f32x4* pk = (const f32x4*)(park + (size_t)tid * 64);
#pragma unroll
              for (int db = 0; db < 4; ++db)
#pragma unroll
                for (int g = 0; g < 4; ++g) { const f32x4 pv = pk[db * 4 + g];
#pragma unroll
                    for (int e = 0; e < 4; ++e) { const float v = pv[e] - lam * o[db][4 * g + e]; o[db][4 * g + e] = v; ssq += v * v; } } }
            ssq = xor32_sum(ssq);
            const float rs = (1.0f / sqrtf(ssq * (1.f / 128.f) + EPS)) * (1.0f - lam_init);
            const float* sg = (const float*)a.in[6] + (size_t)layer * 128;
#pragma unroll
            for (int db = 0; db < 4; ++db)
#pragma unroll
                for (int g = 0; g < 4; ++g) { const f32x4 gg = *(const f32x4*)(sg + 32 * db + 8 * g + 4 * hi);
#pragma unroll
                    for (int e = 0; e < 4; ++e) o[db][4 * g + e] *= rs * gg[e]; }
            store_y<4>(Y + (size_t)T * 512, o, tok0 + q0 + 32 * wid + r32, h * 128, hi);
        } else if (u < 3072) {
            const int i = u - 1024, qb = 31 - (i >> 6), bh = i & 63, b = bh >> 3, h = bh & 7, tok0 = b * S, q0 = qb * 256;
            f32x16 o[2];
            attn_pass<2, 64>(lds, QK, VT, F + (size_t)bh * S, tok0, 2048 + h * 64, 2560 + h * 64, 1024 + h * 64, q0, 0, 4 * qb + 3, o);
            store_y<2>(Y + (size_t)2 * T * 512, o, tok0 + q0 + 32 * wid + r32, h * 64, hi);
        } else {
            const int i = u - 3072, qb = i >> 6, bh = i & 63, b = bh >> 3, h = bh & 7, tok0 = b * S, q0 = qb * 256;
            LAS float* rb = (LAS float*)(lds + OFF_RB);
            if (tid < 257) rb[tid] = ((const float*)a.in[4])[((size_t)layer * 8 + h) * 257 + tid] * LOG2E;
            f32x16 o[2];
            const int t_lo = (4 * qb - 8) < 0 ? 0 : (4 * qb - 8);
            attn_pass<0, 64>(lds, QK, VT, nullptr, tok0, h * 64, 512 + h * 64, h * 64, q0, t_lo, 4 * qb + 3, o);
            store_y<2>(Y, o, tok0 + q0 + 32 * wid + r32, h * 64, hi);
        }
    }
}
}


#define XB_TMO      128
#define XB_XCNT(j)  (256  + 64 * (j))
#define XB_XSUB(j)  (1280 + 64 * (j))
#define XB_XGEN(j)  (2304 + 64 * (j))
#define XB_TOP      3328
#define XB_TOPGEN   3392
#define XCD_BAR_WORDS 3456
#define XB_SPIN_CAP (1u << 30)

__device__ __forceinline__ unsigned xb_ld(unsigned* p)              { return __hip_atomic_load(p, __ATOMIC_RELAXED, __HIP_MEMORY_SCOPE_AGENT); }
__device__ __forceinline__ unsigned xb_add(unsigned* p, unsigned v) { return __hip_atomic_fetch_add(p, v, __ATOMIC_RELAXED, __HIP_MEMORY_SCOPE_AGENT); }
__device__ __forceinline__ unsigned xb_xcc_id() { return (unsigned)__builtin_amdgcn_s_getreg((3 << 11) | 20) & 0xFu; }
#define XB_SPIN(cond, bar) do { unsigned _sp = 0; while (cond) { __builtin_amdgcn_s_sleep(1); \
    if ((++_sp & 255u) == 0u) { if (xb_ld(&(bar)[XB_TMO])) break; if (_sp > XB_SPIN_CAP) { atomicAdd(&(bar)[XB_TMO], 1u); break; } } } } while (0)

struct XcdBarrier {
    unsigned* bar; unsigned x;
    volatile LAS unsigned* st;
};

__device__ __forceinline__ XcdBarrier xcd_barrier_post(unsigned* bar, volatile LAS unsigned* st) {
    XcdBarrier b; b.bar = bar; b.x = xb_xcc_id(); b.st = st;
    if (threadIdx.x == 0) (void)xb_add(&bar[XB_XCNT(b.x)], 1u);
    return b;
}
__device__ __forceinline__ void xcd_barrier_complete(unsigned* bar, unsigned x, unsigned& nloc, unsigned& nx) {
    const unsigned G = gridDim.x * gridDim.y * gridDim.z;
    unsigned sum, cnt, mine, sp = 0u;
    for (;;) {
        sum = 0u; cnt = 0u; mine = 0u;
#pragma unroll
        for (unsigned j = 0; j < 16; ++j) { const unsigned c = xb_ld(&bar[XB_XCNT(j)]); sum += c; cnt += (c > 0u) ? 1u : 0u; mine = (j == x) ? c : mine; }
        if (sum == G) break;
        __builtin_amdgcn_s_sleep(1);
        if ((++sp & 255u) == 0u) { if (xb_ld(&bar[XB_TMO])) break; if (sp > XB_SPIN_CAP) { atomicAdd(&bar[XB_TMO], 1u); break; } }
    }
    nloc = mine > 0u ? mine : 1u; nx = cnt > 0u ? cnt : 1u;
}

__device__ __forceinline__ void xcd_barrier(const XcdBarrier& b) {
    asm volatile("s_waitcnt vmcnt(0)" ::: "memory");
    __syncthreads();
    if (threadIdx.x == 0) {
        unsigned* bar = b.bar;
        __builtin_amdgcn_s_waitcnt(0);
        unsigned nloc = b.st[0], nx = b.st[1];
        if (nloc == 0u) { xcd_barrier_complete(bar, b.x, nloc, nx); b.st[0] = nloc; b.st[1] = nx; }
        const unsigned old = xb_add(&bar[XB_XSUB(b.x)], 1u);
        const unsigned gen = old / nloc;
        if (old + 1u == (gen + 1u) * nloc) {
            __builtin_amdgcn_fence(__ATOMIC_RELEASE, "agent");
            asm volatile("s_waitcnt vmcnt(0)" ::: "memory");
            const unsigned og = xb_add(&bar[XB_TOP], 1u);
            const unsigned tg = og / nx;
            if (og + 1u == (tg + 1u) * nx) xb_add(&bar[XB_TOPGEN], 1u);
            else XB_SPIN(xb_ld(&bar[XB_TOPGEN]) == tg, bar);
            __builtin_amdgcn_fence(__ATOMIC_ACQUIRE, "agent");
            xb_add(&bar[XB_XGEN(b.x)], 1u);
            asm volatile("s_waitcnt vmcnt(0)" ::: "memory");
        } else {
            XB_SPIN(xb_ld(&bar[XB_XGEN(b.x)]) == gen, bar);
            __builtin_amdgcn_fence(__ATOMIC_ACQUIRE, "agent");
            asm volatile("s_waitcnt vmcnt(0)" ::: "memory");
        }
    }
    __syncthreads();
}

#define GEMM_CALL(EPI, A_, B_, M_, N_, K_, E_) do { pg8::Gemm g_{(const pg8::bf16_t*)(A_), (const pg8::bf16_t*)(B_), (M_), (N_), (K_)}; pg8::StaticOrder S_; S_.init((M_), (N_), (int)gridDim.x, (int)blockIdx.x); \
        pg8::gemm_phase<EPI, pg8::StaticOrder, true, true>(lds3, g_, S_, (E_)); } while (0)
typedef __attribute__((address_space(1))) unsigned char gu8_t;
__device__ __forceinline__ unsigned char* opaque_ptr(const void* p) { gu8_t* g = (gu8_t*)p; asm volatile("" : "+s"(g)); return (unsigned char*)g; }
#define WSB(off) (opaque_ptr(a.ws) + (off))
#define INF(i) ((const float*)opaque_ptr(a.in[i]))
#define GRID_BAR() do { XcdBarrier b_; b_.bar = (unsigned*)WSB(WS_CTL) + CW_BAR; b_.x = xb_xcc_id(); b_.st = (volatile LAS unsigned*)(lds3 + MISC_OFF) + 8; xcd_barrier(b_); } while (0)
__global__ void __launch_bounds__(512, 2) fwd_kernel(Args a) {
    extern __shared__ __attribute__((aligned(16))) unsigned char lds[];
    cg::grid_group grid = cg::this_grid();
    LAS unsigned char* lds3 = (LAS unsigned char*)lds;
    const int G = gridDim.x; const int bx = blockIdx.x;
    const int vcu = (G % 8 == 0) ? (bx % 8) * (G / 8) + bx / 8 : bx;
    const int NGW = G * 8;
    {
        const int tid = threadIdx.x, lane = tid & 63; const int wave = __builtin_amdgcn_readfirstlane(tid >> 6); const int gw = vcu * 8 + wave;
        if (tid < 64) ((LAS unsigned*)(lds3 + MISC_OFF))[tid] = 0u;
        __syncthreads();
        (void)xcd_barrier_post((unsigned*)WSB(WS_CTL) + CW_BAR, (volatile LAS unsigned*)(lds3 + MISC_OFF) + 8);
        grid.sync();
        convert_weights(a, lds3, gw, NGW, wave, lane);
        __syncthreads();
        rmsnorm_phase<1>(INF(0), INF(2), (bf16_t*)WSB(WS_H), nullptr, INF(3), INF(7), (float*)WSB(WS_F), lds3, gw, NGW, tid, lane);
        rope_table_phase((float*)WSB(WS_ROPE), (const int*)opaque_ptr(a.in[1]), gw, NGW, lane);
        GRID_BAR();
    }
#pragma unroll 1
    for (int l = 0; l < DEPTH; ++l) {
        int tid_ = threadIdx.x; asm volatile("" : "+v"(tid_));
        const int tid = tid_, lane = tid & 63; const int wave = __builtin_amdgcn_readfirstlane(tid >> 6); const int gw = vcu * 8 + wave;
        const size_t wlo = WS_W + (size_t)l * W_LAYER;
        fcumsum((float*)WSB(WS_F), lds3, tid, lane, wave);
        { pg8::EpiBf<1> E{(bf16_t*)WSB(WS_QK), (size_t)QKW, nullptr, C2}; GEMM_CALL(pg8::EpiBf<1>, WSB(WS_H), WSB(wlo + WO_QK), T, QKW, D, E); }
        { pg8::EpiBf<0> E{(bf16_t*)WSB(WS_VT), (size_t)T, nullptr, 1.f}; GEMM_CALL(pg8::EpiBf<0>, WSB(wlo + WO_V), WSB(WS_H), VW, T, D, E); }
        GRID_BAR();
        rope_phase((bf16_t*)WSB(WS_QK), (const float*)WSB(WS_ROPE), gw, NGW, lane);
        GRID_BAR();
        att::attention_phase(a, lds3, l, (unsigned*)WSB(WS_CTL) + 256 + 256 * l);
        GRID_BAR();
        { pg8::EpiBf<0> E{(bf16_t*)WSB(WS_G), (size_t)GW, nullptr, 1.f}; GEMM_CALL(pg8::EpiBf<0>, WSB(WS_H), WSB(wlo + WO_G), T, GW, D, E); }
        GRID_BAR();
        { pg8::EpiBranchAll E{(bf16_t*)WSB(WS_MG), (const bf16_t*)WSB(WS_G), INF(12) + (size_t)l * GW, T / 256, D / 256};
          pg8::Gemm g_{(const pg8::bf16_t*)WSB(WS_Y), (const pg8::bf16_t*)WSB(wlo + WO_BR), 3 * T, 3 * D, 512}; pg8::BranchOrder S_; S_.init(T, D, (int)gridDim.x, (int)blockIdx.x);
          pg8::gemm_phase<pg8::EpiBranchAll, pg8::BranchOrder, true, true>(lds3, g_, S_, E); }
        GRID_BAR();
        { float* out = (float*)opaque_ptr(a.out); pg8::EpiResidN E{l == 0 ? INF(0) : (const float*)out, out, (bf16_t*)WSB(WS_H), (float*)WSB(WS_Y)}; GEMM_CALL(pg8::EpiResidN, WSB(WS_MG), WSB(wlo + WO_O), T, D, D, E); }
        GRID_BAR();
        {
          const float* sp = (const float*)WSB(WS_Y); float* rs2 = (float*)WSB(WS_Y + 4 * MiB);
          for (int row = (int)blockIdx.x * 512 + tid; row < T; row += (int)gridDim.x * 512) { const f32x4* q4 = (const f32x4*)(sp + (size_t)row * 16);
              const f32x4 a0 = q4[0], a1 = q4[1], a2 = q4[2], a3 = q4[3];
              const float ss = ((a0.x + a0.y) + (a0.z + a0.w)) + ((a1.x + a1.y) + (a1.z + a1.w)) + ((a2.x + a2.y) + (a2.z + a2.w)) + ((a3.x + a3.y) + (a3.z + a3.w));
              rs2[row] = 1.0f / (ss * (1.f / D) + EPS); } }
        GRID_BAR();
        { pg8::EpiBf<4> E{(bf16_t*)WSB(WS_FFH), (size_t)FF, (const float*)WSB(WS_Y + 4 * MiB), 1.f}; GEMM_CALL(pg8::EpiBf<4>, WSB(WS_H), WSB(wlo + WO_1), T, FF, D, E); }
        GRID_BAR();
        { float* out = (float*)opaque_ptr(a.out); pg8::EpiResid E{(const float*)out, out}; GEMM_CALL(pg8::EpiResid, WSB(WS_FFH), WSB(wlo + WO_2), T, D, FF, E); }
        GRID_BAR();
        { float* out = (float*)opaque_ptr(a.out);
          if (l + 1 < DEPTH) rmsnorm_phase<1>(out, INF(2) + (size_t)(l + 1) * D, (bf16_t*)WSB(WS_H), nullptr, INF(3) + (size_t)(l + 1) * D * INW, INF(7) + (size_t)(l + 1) * 8, (float*)WSB(WS_F), lds3, gw, NGW, tid, lane);
          else rmsnorm_phase<2>(out, INF(17), nullptr, out, nullptr, nullptr, nullptr, lds3, gw, NGW, tid, lane); }
        GRID_BAR();
    }
}

extern "C" void kernel_launch(void* const* d_in, const int* in_sizes, int n_in, void* d_out, int out_size, void* d_ws, size_t ws_size, hipStream_t stream) {
    static int grid = 0;
    if (grid == 0) {
        if (n_in != 18 || in_sizes[0] != T * D || out_size != T * D || ws_size < WS_END) { fprintf(stderr, "kernel_launch: unexpected shapes (n_in %d, in0 %d, out %d, ws %zu; need ws >= %zu)\n", n_in, n_in > 0 ? in_sizes[0] : -1, out_size, ws_size, (size_t)WS_END); grid = -1; return; }
        int dev = 0, cus = 0, per_cu = 0;
        if (hipGetDevice(&dev) != hipSuccess || hipDeviceGetAttribute(&cus, hipDeviceAttributeMultiprocessorCount, dev) != hipSuccess) { fprintf(stderr, "kernel_launch: device query failed\n"); grid = -1; return; }
        if (hipFuncSetAttribute((const void*)fwd_kernel, hipFuncAttributeMaxDynamicSharedMemorySize, LDS_BYTES) != hipSuccess) { fprintf(stderr, "kernel_launch: hipFuncSetAttribute failed\n"); grid = -1; return; }
        if (hipOccupancyMaxActiveBlocksPerMultiprocessor(&per_cu, (const void*)fwd_kernel, 512, LDS_BYTES) != hipSuccess || per_cu < 1) { fprintf(stderr, "kernel_launch: occupancy query says %d blocks per CU\n", per_cu); (void)hipGetLastError(); per_cu = 1; }
        grid = cus * 1;
    }
    if (grid < 0) return;
    if (hipMemsetAsync((char*)d_ws + WS_CTL, 0, CTL_ZERO_BYTES, stream) != hipSuccess) { fprintf(stderr, "kernel_launch: memset failed\n"); return; }
    Args a{};
    for (int i = 0; i < 18; ++i) a.in[i] = d_in[i];
    a.out = (float*)d_out; a.ws = (unsigned char*)d_ws;
    void* params[] = {&a};
    hipError_t e = hipLaunchCooperativeKernel((const void*)fwd_kernel, dim3(grid), dim3(512), params, LDS_BYTES, stream);
    if (e != hipSuccess) fprintf(stderr, "kernel_launch: cooperative launch failed: %s (grid %d)\n", hipGetErrorString(e), grid);
}
```
